# Optimizing an MI355X kernel written in HIP

```python
import jax
import jax.numpy as jnp
from jax import lax
import numpy as np

D_MODEL = 2048
BATCH = 16
SEQ = 2048
DEPTH = 2

HEAD_DIM = 128
MEM_TOKENS = 256
MEM_HEADS = 4
MEM_WIDTH = MEM_HEADS * HEAD_DIM
CONV_WIDTH = D_MODEL - MEM_WIDTH
CONV_SIZE = 3
NSA_HEADS = (D_MODEL - MEM_WIDTH) // HEAD_DIM
NSA_KV_HEADS = 4
NSA_GROUP = NSA_HEADS // NSA_KV_HEADS
NSA_WIDTH = NSA_HEADS * HEAD_DIM
KV_BRANCH_WIDTH = NSA_KV_HEADS * HEAD_DIM
KV_WIDTH = 6 * KV_BRANCH_WIDTH
CMP_BLOCK = 32
CMP_STRIDE = 16
CMP_HIDDEN = 256
SLC_BLOCK = 64
SLC_TOPK = 16
WINDOW = 512
Q_BLOCK = 128
SLC_Q_BLOCK = 64
N_A = DEPTH // 2
N_B = DEPTH - N_A
A_IN = 4 * CONV_WIDTH + 2 * MEM_WIDTH
B_IN = 2 * NSA_WIDTH + 3 * NSA_HEADS + 2 * MEM_WIDTH
EPS = 1e-6
NEG = -1e30
FORCE = 1e4
SCALE = HEAD_DIM ** -0.5

kernel_name = 'hybrid_shortconv_nsa_yoco_mem'


def rmsnorm(x, g):
    xf = x.astype(jnp.float32)
    y = xf * lax.rsqrt(jnp.mean(xf * xf, axis=-1, keepdims=True) + EPS)
    return (y * g.astype(jnp.float32)).astype(x.dtype)


def split_cols(u, widths):
    cuts = np.cumsum(widths)[:-1].tolist()
    return jnp.split(u, cuts, axis=-1)


def heads(t, n):
    return t.reshape(t.shape[:-1] + (n, HEAD_DIM))


def masked_softmax(logits, mask):
    l = jnp.where(mask, logits.astype(jnp.float32), NEG)
    p = jax.nn.softmax(l, axis=-1)
    return jnp.where(mask, p, 0.0)


def memory_attention(q_in, mem, mem_norm, w_kv, q_gain, k_gain):
    bn, s = q_in.shape[:2]
    q = rmsnorm(heads(q_in, MEM_HEADS), q_gain)
    mk, mv = jnp.split(rmsnorm(mem, mem_norm) @ w_kv, 2, axis=-1)
    mk = rmsnorm(heads(mk, MEM_HEADS), k_gain)
    mv = heads(mv, MEM_HEADS)
    sc = jnp.einsum('bshd,bmhd->bhsm', q, mk).astype(jnp.float32) * SCALE
    p = jax.nn.softmax(sc, axis=-1).astype(mv.dtype)
    return jnp.einsum('bhsm,bmhd->bshd', p, mv).reshape(bn, s, MEM_WIDTH)


def short_conv(cb, cc, ch, w, b):
    u = cc * ch
    y = lax.conv_general_dilated(
        u, w.astype(u.dtype)[:, None, :], window_strides=(1,),
        padding=[(CONV_SIZE - 1, 0)], dimension_numbers=('NWC', 'WIO', 'NWC'),
        feature_group_count=u.shape[-1])
    return cb * (y + b)


def conv_layer(x, mem, norm, w_in, conv_w, conv_b, w_out, mem_norm, mem_w_kv, mem_qn, mem_kn):
    h = rmsnorm(x, norm)
    cb, cc, ch, cz, mq, mz = split_cols(h @ w_in, [CONV_WIDTH] * 4 + [MEM_WIDTH] * 2)
    y_conv = short_conv(cb, cc, ch, conv_w, conv_b) * jax.nn.silu(cz)
    y_mem = memory_attention(mq, mem, mem_norm, mem_w_kv, mem_qn, mem_kn) * jax.nn.silu(mz)
    return x + jnp.concatenate([y_conv, y_mem], axis=-1) @ w_out


def compress(t, pos, w1, w2):
    bn, s = t.shape[:2]
    n_chunks = s // CMP_STRIDE
    r = CMP_BLOCK // CMP_STRIDE
    c = t.reshape(bn, n_chunks, CMP_STRIDE, NSA_KV_HEADS, HEAD_DIM)
    blk = jnp.concatenate([c[:, i:n_chunks - r + 1 + i] for i in range(r)], axis=2)
    hid = jax.nn.silu(jnp.einsum('bclgd,ldf->bcgf', blk + pos[:, None, :], w1))
    return hid @ w2


def shared_nsa_kv(x, kv_norm, kv_w, pos_k, w1_k, w2_k, pos_v, w1_v, w2_v, kn_cmp, kn_slc, kn_win):
    kv = rmsnorm(x, kv_norm) @ kv_w
    kc, vc, ks, vs, kw, vw = [heads(t, NSA_KV_HEADS) for t in jnp.split(kv, 6, axis=-1)]
    k_cmp = rmsnorm(compress(kc, pos_k, w1_k, w2_k), kn_cmp)
    v_cmp = compress(vc, pos_v, w1_v, w2_v)
    return k_cmp, v_cmp, rmsnorm(ks, kn_slc), vs, rmsnorm(kw, kn_win), vw


def compressed_branch(q, k_cmp, v_cmp):
    s = q.shape[1]
    n_c = k_cmp.shape[1]
    sc = jnp.einsum('bsgjd,bcgd->bgjsc', q, k_cmp).astype(jnp.float32) * SCALE
    t = jnp.arange(s)[:, None]
    c = jnp.arange(n_c)[None, :]
    mask = c * CMP_STRIDE + CMP_BLOCK - 1 <= t
    p = masked_softmax(sc, mask)
    o = jnp.einsum('bgjsc,bcgd->bsgjd', p.astype(v_cmp.dtype), v_cmp)
    return o, p.sum(axis=2)


def select_blocks(importance):
    s, n_c = importance.shape[2:]
    n_s = s // SLC_BLOCK
    n_sel = min(SLC_TOPK, n_s)
    i = jnp.arange(n_c)[:, None]
    j = jnp.arange(n_s)[None, :]
    cover = ((i * CMP_STRIDE < (j + 1) * SLC_BLOCK) &
             (i * CMP_STRIDE + CMP_BLOCK > j * SLC_BLOCK)).astype(jnp.float32)
    score = jnp.einsum('bgsc,cj->bgsj', importance.astype(jnp.float32), cover)
    t = jnp.arange(s)[:, None]
    cur = t // SLC_BLOCK
    allowed = j * SLC_BLOCK <= t
    forced = (j == 0) | (j == cur) | (j == cur - 1)
    score = jnp.where(forced, FORCE, jnp.where(allowed, score, NEG))
    _, idx = lax.top_k(score, n_sel)
    valid = idx * SLC_BLOCK <= jnp.arange(s)[:, None]
    return idx, valid


def selected_branch(q, k_s, v_s, idx, valid):
    bn, s, g, j, d = q.shape
    n_s = s // SLC_BLOCK
    n_q = s // SLC_Q_BLOCK
    n = idx.shape[-1]
    kb = k_s.reshape(bn, n_s, SLC_BLOCK, g, d).transpose(0, 3, 1, 2, 4)
    vb = v_s.reshape(bn, n_s, SLC_BLOCK, g, d).transpose(0, 3, 1, 2, 4)
    qc = q.reshape(bn, n_q, SLC_Q_BLOCK, g, j, d)
    ic = idx.reshape(bn, g, n_q, SLC_Q_BLOCK, n).transpose(0, 2, 1, 3, 4)
    vc = valid.reshape(bn, g, n_q, SLC_Q_BLOCK, n).transpose(0, 2, 1, 3, 4)
    t_c = jnp.arange(s).reshape(n_q, SLC_Q_BLOCK)
    g_ix = jnp.arange(g)[:, None, None]
    offs = jnp.arange(SLC_BLOCK)

    def per_block(q_blk, i_blk, v_blk, t_blk, kbg, vbg):
        tq = t_blk.shape[0]
        k_sel = kbg[g_ix, i_blk]
        v_sel = vbg[g_ix, i_blk].reshape(g, tq, n * SLC_BLOCK, d)
        pos = i_blk[..., None] * SLC_BLOCK + offs
        mask = (pos <= t_blk[None, :, None, None]) & v_blk[..., None]
        sc = jnp.einsum('tgjd,gtnkd->gjtnk', q_blk, k_sel).astype(jnp.float32) * SCALE
        sc = sc.reshape(g, j, tq, n * SLC_BLOCK)
        p = masked_softmax(sc, mask.reshape(g, 1, tq, n * SLC_BLOCK)).astype(v_sel.dtype)
        return jnp.einsum('gjtm,gtmd->tgjd', p, v_sel)

    def per_batch(args):
        q_b, i_b, v_b, kbg, vbg = args
        return lax.map(lambda a: per_block(a[0], a[1], a[2], a[3], kbg, vbg), (q_b, i_b, v_b, t_c))

    o = lax.map(per_batch, (qc, ic, vc, kb, vb))
    return o.reshape(bn, s, g, j, d)


def window_branch(q, k_w, v_w):
    bn, s, g, j, d = q.shape
    n_q = s // Q_BLOCK
    span = WINDOW + Q_BLOCK
    kp = jnp.pad(k_w, ((0, 0), (WINDOW, 0), (0, 0), (0, 0)))
    vp = jnp.pad(v_w, ((0, 0), (WINDOW, 0), (0, 0), (0, 0)))

    def per_block(c):
        start = c * Q_BLOCK
        q_blk = lax.dynamic_slice_in_dim(q, start, Q_BLOCK, axis=1)
        k_blk = lax.dynamic_slice_in_dim(kp, start, span, axis=1)
        v_blk = lax.dynamic_slice_in_dim(vp, start, span, axis=1)
        t = start + jnp.arange(Q_BLOCK)
        p_pos = start - WINDOW + jnp.arange(span)
        diff = t[:, None] - p_pos[None, :]
        mask = (diff >= 0) & (diff < WINDOW) & (p_pos[None, :] >= 0)
        sc = jnp.einsum('btgjd,bpgd->bgjtp', q_blk, k_blk).astype(jnp.float32) * SCALE
        pr = masked_softmax(sc, mask).astype(v_blk.dtype)
        return jnp.einsum('bgjtp,bpgd->btgjd', pr, v_blk)

    o = lax.map(per_block, jnp.arange(n_q))
    return o.transpose(1, 0, 2, 3, 4, 5).reshape(bn, s, g, j, d)


def nsa_layer(x, mem, shared, norm, w_in, gate_bias, q_gain, w_out, mem_norm, mem_w_kv, mem_qn, mem_kn):
    bn, s, _ = x.shape
    h = rmsnorm(x, norm)
    q, gl, z, mq, mz = split_cols(h @ w_in, [NSA_WIDTH, 3 * NSA_HEADS, NSA_WIDTH, MEM_WIDTH, MEM_WIDTH])
    q = rmsnorm(heads(q, NSA_HEADS), q_gain).reshape(bn, s, NSA_KV_HEADS, NSA_GROUP, HEAD_DIM)
    gates = jax.nn.sigmoid(gl + gate_bias).reshape(bn, s, NSA_KV_HEADS, NSA_GROUP, 3)
    k_cmp, v_cmp, k_s, v_s, k_w, v_w = shared
    o_cmp, importance = compressed_branch(q, k_cmp, v_cmp)
    idx, valid = select_blocks(importance)
    o_slc = selected_branch(q, k_s, v_s, idx, valid)
    o_win = window_branch(q, k_w, v_w)
    o = gates[..., 0:1] * o_cmp + gates[..., 1:2] * o_slc + gates[..., 2:3] * o_win
    y_nsa = o.reshape(bn, s, NSA_WIDTH) * jax.nn.silu(z)
    y_mem = memory_attention(mq, mem, mem_norm, mem_w_kv, mem_qn, mem_kn) * jax.nn.silu(mz)
    return x + jnp.concatenate([y_nsa, y_mem], axis=-1) @ w_out


def setup_inputs(seed: int = 0) -> dict:
    key = jax.random.key(seed)
    ks = jax.random.split(key, 32)
    f32 = jnp.float32
    d = D_MODEL

    def nrm(k, shape, scale):
        return jax.random.normal(k, shape, f32) * scale

    def gain(k, shape):
        return 1.0 + 0.01 * jax.random.normal(k, shape, f32)

    cmp_in = (CMP_BLOCK * HEAD_DIM) ** -0.5
    return {
        'x': nrm(ks[0], (BATCH, SEQ, d), 1.0),
        'mem': nrm(ks[1], (BATCH, MEM_TOKENS, d), 1.0),
        'a_norm': gain(ks[2], (N_A, d)),
        'a_w_in': nrm(ks[3], (N_A, d, A_IN), d ** -0.5),
        'a_conv_w': nrm(ks[4], (N_A, CONV_SIZE, CONV_WIDTH), CONV_SIZE ** -0.5),
        'a_conv_b': nrm(ks[5], (N_A, CONV_WIDTH), 0.01),
        'a_w_out': nrm(ks[6], (N_A, d, d), d ** -0.5),
        'kv_norm': gain(ks[7], (d,)),
        'kv_w': nrm(ks[8], (d, KV_WIDTH), d ** -0.5),
        'cmp_pos_k': nrm(ks[9], (CMP_BLOCK, HEAD_DIM), 0.1),
        'cmp_w1_k': nrm(ks[10], (CMP_BLOCK, HEAD_DIM, CMP_HIDDEN), cmp_in),
        'cmp_w2_k': nrm(ks[11], (CMP_HIDDEN, HEAD_DIM), CMP_HIDDEN ** -0.5),
        'cmp_pos_v': nrm(ks[12], (CMP_BLOCK, HEAD_DIM), 0.1),
        'cmp_w1_v': nrm(ks[13], (CMP_BLOCK, HEAD_DIM, CMP_HIDDEN), cmp_in),
        'cmp_w2_v': nrm(ks[14], (CMP_HIDDEN, HEAD_DIM), CMP_HIDDEN ** -0.5),
        'kn_cmp': gain(ks[15], (HEAD_DIM,)),
        'kn_slc': gain(ks[16], (HEAD_DIM,)),
        'kn_win': gain(ks[17], (HEAD_DIM,)),
        'b_norm': gain(ks[18], (N_B, d)),
        'b_w_in': nrm(ks[19], (N_B, d, B_IN), d ** -0.5),
        'b_gate_bias': nrm(ks[20], (N_B, 3 * NSA_HEADS), 0.01),
        'b_q_norm': gain(ks[21], (N_B, HEAD_DIM)),
        'b_w_out': nrm(ks[22], (N_B, d, d), d ** -0.5),
        'mem_norm': gain(ks[23], (DEPTH, d)),
        'mem_w_kv': nrm(ks[24], (DEPTH, d, 2 * MEM_WIDTH), d ** -0.5),
        'mem_q_norm': gain(ks[25], (DEPTH, HEAD_DIM)),
        'mem_k_norm': gain(ks[26], (DEPTH, HEAD_DIM)),
    }


def reference(x, mem, a_norm, a_w_in, a_conv_w, a_conv_b, a_w_out, kv_norm, kv_w,
              cmp_pos_k, cmp_w1_k, cmp_w2_k, cmp_pos_v, cmp_w1_v, cmp_w2_v,
              kn_cmp, kn_slc, kn_win, b_norm, b_w_in, b_gate_bias, b_q_norm, b_w_out,
              mem_norm, mem_w_kv, mem_q_norm, mem_k_norm):
    shared = None
    for layer in range(DEPTH):
        mem_p = (mem_norm[layer], mem_w_kv[layer], mem_q_norm[layer], mem_k_norm[layer])
        if layer < N_A:
            x = conv_layer(x, mem, a_norm[layer], a_w_in[layer], a_conv_w[layer],
                           a_conv_b[layer], a_w_out[layer], *mem_p)
        else:
            if layer == N_A:
                shared = shared_nsa_kv(x, kv_norm, kv_w, cmp_pos_k, cmp_w1_k, cmp_w2_k,
                                       cmp_pos_v, cmp_w1_v, cmp_w2_v, kn_cmp, kn_slc, kn_win)
            i = layer - N_A
            x = nsa_layer(x, mem, shared, b_norm[i], b_w_in[i], b_gate_bias[i], b_q_norm[i],
                          b_w_out[i], *mem_p)
    return x
```

```cpp
#include <hip/hip_runtime.h>
#include <hip/hip_cooperative_groups.h>
#include <cstdio>
#include <cstdint>
namespace cg = cooperative_groups;

typedef unsigned short u16;
typedef __attribute__((ext_vector_type(8))) short bf16x8;
typedef __attribute__((ext_vector_type(4))) short s16x4;
typedef __attribute__((ext_vector_type(16))) float f32x16;
typedef __attribute__((ext_vector_type(4))) unsigned u32x4;
typedef __attribute__((ext_vector_type(2))) __bf16 bf2_t;
typedef __attribute__((ext_vector_type(2))) float f2_t;
#define DI __device__ __forceinline__
#define TIDX() ({ int t_; asm volatile("v_mbcnt_lo_u32_b32 %0, -1, 0\n\tv_mbcnt_hi_u32_b32 %0, -1, %0\n\tv_lshl_or_b32 %0, %1, 6, %0" : "=&v"(t_) : "s"(wid_s)); t_; })
#define MFMA(a, b, c) __builtin_amdgcn_mfma_f32_32x32x16_bf16((a), (b), (c), 0, 0, 0)

#ifndef PROBE_G
#define PROBE_G 1
#endif
#ifndef PROBE_A
#define PROBE_A 1
#endif
#ifndef PROBE_M
#define PROBE_M 1
#endif
#ifndef PROBE_REP_U
#define PROBE_REP_U 1
#endif
#ifndef PROBE_REP_ATT
#define PROBE_REP_ATT 1
#endif
constexpr int T = 32768, SEQ = 2048;
constexpr int LDU = 7168, LDQG = 4224, LDKV = 3072;
constexpr float EPS = 1e-6f;
constexpr float QMULT = 0.08838834764831845f * 1.4426950408889634f;

constexpr size_t MiB = 1ull << 20;
constexpr size_t OFF_WA_IN = 0, OFF_WA_OUT = 28 * MiB, OFF_WKV = 36 * MiB, OFF_WB_IN = 48 * MiB, OFF_WB_OUT = 65 * MiB;
constexpr size_t OFF_WMEM = 73 * MiB, OFF_W1 = 81 * MiB, OFF_W2 = 85 * MiB;
constexpr size_t OFF_BIASP = 85 * MiB + 256 * 1024, OFF_BIAS = 85 * MiB + 512 * 1024;
constexpr size_t OFF_MEMH = 88 * MiB, OFF_MEMK = 120 * MiB, OFF_MEMVT = 128 * MiB;
constexpr size_t OFF_HID = 136 * MiB, OFF_KC = 144 * MiB, OFF_VCT = 146 * MiB, OFF_SEL = 148 * MiB;
constexpr size_t OFF_BAR = 159 * MiB;
constexpr size_t OFF_H1 = 160 * MiB;
constexpr size_t OFF_VTS = 160 * MiB, OFF_VTW = 192 * MiB;
constexpr size_t OFF_U = 288 * MiB;
constexpr size_t OFF_HKV = 288 * MiB, OFF_HB = 416 * MiB, OFF_KV = 544 * MiB, OFF_Y2 = 288 * MiB, OFF_OSUM = 416 * MiB;
constexpr size_t OFF_QG = 736 * MiB;
constexpr size_t OFF_PART = 512 * MiB;

constexpr int NTHR = 512;
constexpr int STG_WAVE = 32 * 272;
constexpr int LDS_BYTES = 147456;
constexpr int GEMM_BUF = 512 * 144;
constexpr int ATT_BUF = 2 * 128 * 272;

struct Params {
  const float *x, *mem, *a_norm, *a_w_in, *a_conv_w, *a_conv_b, *a_w_out, *kv_norm, *kv_w;
  const float *cmp_pos_k, *cmp_w1_k, *cmp_w2_k, *cmp_pos_v, *cmp_w1_v, *cmp_w2_v, *kn_cmp, *kn_slc, *kn_win;
  const float *b_norm, *b_w_in, *b_gate_bias, *b_q_norm, *b_w_out, *mem_norm, *mem_w_kv, *mem_q_norm, *mem_k_norm;
  float* out;
  char* ws;
};

DI unsigned pk2(float a, float b) {
  f2_t v = {a, b};
  bf2_t r = __builtin_convertvector(v, bf2_t);
  return __builtin_bit_cast(unsigned, r);
}
DI float bflo(unsigned w) { return __uint_as_float(w << 16); }
DI float bfhi(unsigned w) { return __uint_as_float(w & 0xffff0000u); }
DI void unpack8(uint4 v, float (&f)[8]) {
  f[0] = bflo(v.x); f[1] = bfhi(v.x); f[2] = bflo(v.y); f[3] = bfhi(v.y);
  f[4] = bflo(v.z); f[5] = bfhi(v.z); f[6] = bflo(v.w); f[7] = bfhi(v.w);
}
DI uint4 pack8(const float (&f)[8]) {
  uint4 r; r.x = pk2(f[0], f[1]); r.y = pk2(f[2], f[3]); r.z = pk2(f[4], f[5]); r.w = pk2(f[6], f[7]); return r;
}
DI int crow(int r, int h) { return (r & 3) + 8 * (r >> 2) + 4 * h; }
DI float silu_f(float z) { return z / (1.f + __expf(-z)); }
DI float sigmoid_f(float z) { return 1.f / (1.f + __expf(-z)); }
DI float xor32_max(float v) {
  auto rr = __builtin_amdgcn_permlane32_swap(__float_as_uint(v), __float_as_uint(v), false, false);
  return fmaxf(__uint_as_float(rr[0]), __uint_as_float(rr[1]));
}
DI float xor32_sum(float v) {
  auto rr = __builtin_amdgcn_permlane32_swap(__float_as_uint(v), __float_as_uint(v), false, false);
  return __uint_as_float(rr[0]) + __uint_as_float(rr[1]);
}
DI float xor32_get(float v, int h) {
  auto rr = __builtin_amdgcn_permlane32_swap(__float_as_uint(v), __float_as_uint(v), false, false);
  return __uint_as_float(h ? rr[0] : rr[1]);
}
DI float wave_sum(float v) {
#pragma unroll
  for (int o = 32; o >= 1; o >>= 1) v += __shfl_xor(v, o);
  return v;
}

DI int mapb(int n) {
  if (n < 1536) return n;
  if (n < 4096) return n + 36;
  if (n < 4132) return n - 2560;
  return -1;
}
DI void transpose_tile(int wid_s, const float* __restrict__ src, int Nsrc, u16* __restrict__ dst, int K, int kt, int nt, int mode,
                       const float* __restrict__ kgain, char* lds) {
  float* tile = (float*)lds;
  const int tid = TIDX();
  const int tx = tid & 63, ty = tid >> 6;
  const int np = nt * 64 + tx;
  const int ns = mode ? mapb(np) : np;
  float v[32];
#pragma unroll
  for (int i = 0; i < 32; ++i) {
    const int k = kt * 256 + ty + 8 * i;
    v[i] = ns >= 0 ? src[(long)k * Nsrc + ns] : 0.f;
  }
#pragma unroll
  for (int i = 0; i < 32; ++i) tile[(ty + 8 * i) * 65 + tx] = v[i];
  __syncthreads();
#pragma unroll
  for (int j = 0; j < 4; ++j) {
    const int c = tid + 512 * j;
    const int kk = c & 7, nl = (c >> 3) & 63, kq = c >> 9;
    float f[8];
#pragma unroll
    for (int e = 0; e < 8; ++e) f[e] = tile[(kq * 64 + kk * 8 + e) * 65 + nl];
    if (kgain) {
      const int k0 = kt * 256 + kq * 64 + kk * 8;
      const float4 ga = *(const float4*)(kgain + k0), gb = *(const float4*)(kgain + k0 + 4);
      f[0] *= ga.x; f[1] *= ga.y; f[2] *= ga.z; f[3] *= ga.w; f[4] *= gb.x; f[5] *= gb.y; f[6] *= gb.z; f[7] *= gb.w;
    }
    *(uint4*)(dst + (long)(nt * 64 + nl) * K + kt * 256 + kq * 64 + kk * 8) = pack8(f);
  }
  __syncthreads();
}

DI void rmsnorm_rows(int wid_s, const float* __restrict__ src, int nrows, const float* __restrict__ g1, u16* __restrict__ d1,
                     const float* __restrict__ g2, u16* __restrict__ d2) {
  const int tidl = TIDX();
  const int lane = tidl & 63;
  const int gw = blockIdx.x * 8 + (tidl >> 6), nw = gridDim.x * 8;
  for (int row = gw * 2; row < nrows; row += nw * 2) {
    const float4* s4 = (const float4*)(src + (long)row * 2048);
    float4 v[16];
#pragma unroll
    for (int i = 0; i < 16; ++i) v[i] = s4[i * 64 + lane];
    float ss0 = 0.f, ss1 = 0.f;
#pragma unroll
    for (int i = 0; i < 8; ++i) {
      ss0 += v[i].x * v[i].x + v[i].y * v[i].y + v[i].z * v[i].z + v[i].w * v[i].w;
      ss1 += v[8 + i].x * v[8 + i].x + v[8 + i].y * v[8 + i].y + v[8 + i].z * v[8 + i].z + v[8 + i].w * v[8 + i].w;
    }
    ss0 = wave_sum(ss0);
    ss1 = wave_sum(ss1);
    const float rs0 = rsqrtf(ss0 * (1.f / 2048.f) + EPS), rs1 = rsqrtf(ss1 * (1.f / 2048.f) + EPS);
    const bool odd = lane & 1;
#pragma unroll
    for (int i = 0; i < 16; i += 2) {
      const int cA = ((i & 7) * 64 + lane) * 4, cB = cA + 256;
      const float rs = i < 8 ? rs0 : rs1;
      const long orow = (long)(row + (i >> 3)) * 2048;
      const long o = orow + (odd ? cB - 4 : cA);
      {
        const float4 one4 = make_float4(1.f, 1.f, 1.f, 1.f);
        const float4 gA = g1 ? *(const float4*)(g1 + cA) : one4, gB = g1 ? *(const float4*)(g1 + cB) : one4;
        const unsigned ax = pk2(v[i].x * rs * gA.x, v[i].y * rs * gA.y), ay = pk2(v[i].z * rs * gA.z, v[i].w * rs * gA.w);
        const unsigned bx = pk2(v[i + 1].x * rs * gB.x, v[i + 1].y * rs * gB.y), by = pk2(v[i + 1].z * rs * gB.z, v[i + 1].w * rs * gB.w);
        const unsigned rx = (unsigned)__shfl_xor((int)(odd ? ax : bx), 1), ry = (unsigned)__shfl_xor((int)(odd ? ay : by), 1);
        u32x4 w;
        if (odd) { w[0] = rx; w[1] = ry; w[2] = bx; w[3] = by; } else { w[0] = ax; w[1] = ay; w[2] = rx; w[3] = ry; }
        *(u32x4*)(d1 + o) = w;
      }
      if (d2) {
        const float4 gA = *(const float4*)(g2 + cA), gB = *(const float4*)(g2 + cB);
        const unsigned ax = pk2(v[i].x * rs * gA.x, v[i].y * rs * gA.y), ay = pk2(v[i].z * rs * gA.z, v[i].w * rs * gA.w);
        const unsigned bx = pk2(v[i + 1].x * rs * gB.x, v[i + 1].y * rs * gB.y), by = pk2(v[i + 1].z * rs * gB.z, v[i + 1].w * rs * gB.w);
        const unsigned rx = (unsigned)__shfl_xor((int)(odd ? ax : bx), 1), ry = (unsigned)__shfl_xor((int)(odd ? ay : by), 1);
        u32x4 w;
        if (odd) { w[0] = rx; w[1] = ry; w[2] = bx; w[3] = by; } else { w[0] = ax; w[1] = ay; w[2] = rx; w[3] = ry; }
        *(u32x4*)(d2 + o) = w;
      }
    }
  }
}

DI void rownorm128(int wid_s, u16* base, long outer_stride, int rpg_shift, long nrows, const float* __restrict__ gain) {
  const int tidl = TIDX();
  const int l16 = tidl & 15;
  const long gq = ((long)blockIdx.x * NTHR + tidl) >> 4, nq = ((long)gridDim.x * NTHR) >> 4;
  for (long r = gq; r < nrows; r += nq) {
    u16* ptr = base + (r >> rpg_shift) * outer_stride + (r & ((1 << rpg_shift) - 1)) * 128 + l16 * 8;
    uint4 v = *(const uint4*)ptr;
    float f[8];
    unpack8(v, f);
    float ss = 0.f;
#pragma unroll
    for (int j = 0; j < 8; ++j) ss += f[j] * f[j];
    ss += __shfl_xor(ss, 1); ss += __shfl_xor(ss, 2); ss += __shfl_xor(ss, 4); ss += __shfl_xor(ss, 8);
    const float rs = rsqrtf(ss * (1.f / 128.f) + EPS);
    float4 ga = *(const float4*)(gain + l16 * 8), gb = *(const float4*)(gain + l16 * 8 + 4);
    f[0] *= rs * ga.x; f[1] *= rs * ga.y; f[2] *= rs * ga.z; f[3] *= rs * ga.w;
    f[4] *= rs * gb.x; f[5] *= rs * gb.y; f[6] *= rs * gb.z; f[7] *= rs * gb.w;
    *(uint4*)ptr = pack8(f);
  }
}

DI void conv_pass(int wid_s, const u16* __restrict__ U, const float* __restrict__ cw, const float* __restrict__ cbias, u16* __restrict__ Y) {
  const long total = (long)(T / 4) * 192;
  const long gs = (long)gridDim.x * NTHR;
  const int tidl = TIDX();
  for (long idx = (long)blockIdx.x * NTHR + tidl; idx < total; idx += gs) {
    const int tg = (int)(idx / 192);
    const int c = (int)(idx - (long)tg * 192) * 8;
    const int t0 = tg * 4;
    const bool first = (t0 & (SEQ - 1)) == 0;
    const u16* row = U + (long)t0 * LDU;
    const long hoff = first ? 0 : -2 * (long)LDU;
    uint4 rc[6], rh[6], rb[4], rz[4];
    rc[0] = *(const uint4*)(row + hoff + 1536 + c);           rh[0] = *(const uint4*)(row + hoff + 3072 + c);
    rc[1] = *(const uint4*)(row + hoff / 2 + 1536 + c);       rh[1] = *(const uint4*)(row + hoff / 2 + 3072 + c);
#pragma unroll
    for (int i = 0; i < 4; ++i) {
      rc[2 + i] = *(const uint4*)(row + (long)i * LDU + 1536 + c);
      rh[2 + i] = *(const uint4*)(row + (long)i * LDU + 3072 + c);
      rb[i] = *(const uint4*)(row + (long)i * LDU + c);
      rz[i] = *(const uint4*)(row + (long)i * LDU + 4608 + c);
    }
    float w0[8], w1[8], w2[8], bb[8];
    *(float4*)&w0[0] = *(const float4*)(cw + c); *(float4*)&w0[4] = *(const float4*)(cw + c + 4);
    *(float4*)&w1[0] = *(const float4*)(cw + 1536 + c); *(float4*)&w1[4] = *(const float4*)(cw + 1536 + c + 4);
    *(float4*)&w2[0] = *(const float4*)(cw + 3072 + c); *(float4*)&w2[4] = *(const float4*)(cw + 3072 + c + 4);
    *(float4*)&bb[0] = *(const float4*)(cbias + c); *(float4*)&bb[4] = *(const float4*)(cbias + c + 4);
    float u[6][8];
#pragma unroll
    for (int i = 0; i < 6; ++i) {
      float a[8], b[8];
      unpack8(rc[i], a); unpack8(rh[i], b);
#pragma unroll
      for (int j = 0; j < 8; ++j) u[i][j] = (i < 2 && first) ? 0.f : a[j] * b[j];
    }
#pragma unroll
    for (int i = 0; i < 4; ++i) {
      float fb[8], fz[8], acc[8];
      unpack8(rb[i], fb); unpack8(rz[i], fz);
#pragma unroll
      for (int j = 0; j < 8; ++j) {
        acc[j] = bb[j] + w0[j] * u[i][j] + w1[j] * u[i + 1][j] + w2[j] * u[i + 2][j];
        acc[j] = fb[j] * acc[j] * silu_f(fz[j]);
      }
      *(uint4*)(Y + (long)(t0 + i) * 2048 + c) = pack8(acc);
    }
  }
}

template <class AF, class EF>
DI void gemm_tile(int wid_s, AF af, const u16* __restrict__ Bt, int K, int m0, int n0, EF ef, char* lds) {
  const int tid = TIDX(), lane = tid & 63, wid = wid_s, r32 = lane & 31, h = lane >> 5;
  const int wm = wid >> 1, wn = wid & 1;
  const int lrow = tid >> 3, lch = tid & 7;
  f32x16 acc[2][4];
#pragma unroll
  for (int i = 0; i < 2; ++i)
#pragma unroll
    for (int j = 0; j < 4; ++j)
#pragma unroll
      for (int r = 0; r < 16; ++r) acc[i][j][r] = 0.f;
  u32x4 ra0[4], rb0[4];
  const int nk = K >> 6;
#define G_LOAD(RA, RB, KT)                                                      \
  {                                                                             \
    const int k_ = (KT) * 64 + lch * 8;                                         \
    _Pragma("unroll") for (int i = 0; i < 4; ++i) {                             \
      RA[i] = *(const u32x4*)af(m0 + lrow + 64 * i, k_);                        \
      RB[i] = *(const u32x4*)(Bt + (long)(n0 + lrow + 64 * i) * K + k_);        \
    }                                                                           \
  }
#define G_WRITE(RA, RB, BUF)                                                    \
  {                                                                             \
    char* An_ = lds + (BUF) * GEMM_BUF;                                         \
    _Pragma("unroll") for (int i = 0; i < 4; ++i) {                             \
      *(u32x4*)(An_ + (lrow + 64 * i) * 144 + lch * 16) = RA[i];                \
      *(u32x4*)(An_ + 256 * 144 + (lrow + 64 * i) * 144 + lch * 16) = RB[i];    \
    }                                                                           \
  }
#define G_STEP(RA, RB, BUF)                                                     \
  {                                                                             \
    const char* As = lds + (BUF) * GEMM_BUF + (wm * 64 + r32) * 144 + h * 16;   \
    const char* Bs = lds + (BUF) * GEMM_BUF + (256 + wn * 128 + r32) * 144 + h * 16; \
    char* Wn = lds + ((BUF) ^ 1) * GEMM_BUF + lrow * 144 + lch * 16;            \
    _Pragma("unroll") for (int ks = 0; ks < 4; ++ks) {                          \
      bf16x8 a0 = *(const bf16x8*)(As + ks * 32);                               \
      bf16x8 a1 = *(const bf16x8*)(As + 32 * 144 + ks * 32);                    \
      bf16x8 b0 = *(const bf16x8*)(Bs + ks * 32);                               \
      bf16x8 b1 = *(const bf16x8*)(Bs + 32 * 144 + ks * 32);                    \
      bf16x8 b2 = *(const bf16x8*)(Bs + 64 * 144 + ks * 32);                    \
      bf16x8 b3 = *(const bf16x8*)(Bs + 96 * 144 + ks * 32);                    \
      acc[0][0] = MFMA(a0, b0, acc[0][0]);                                      \
      acc[0][1] = MFMA(a0, b1, acc[0][1]);                                      \
      if (ks == 2) *(u32x4*)(Wn) = RA[0];                                       \
      if (ks == 3) *(u32x4*)(Wn + 256 * 144) = RB[0];                           \
      acc[0][2] = MFMA(a0, b2, acc[0][2]);                                      \
      acc[0][3] = MFMA(a0, b3, acc[0][3]);                                      \
      if (ks == 2) *(u32x4*)(Wn + 64 * 144) = RA[1];                            \
      if (ks == 3) *(u32x4*)(Wn + 320 * 144) = RB[1];                           \
      acc[1][0] = MFMA(a1, b0, acc[1][0]);                                      \
      acc[1][1] = MFMA(a1, b1, acc[1][1]);                                      \
      if (ks == 2) *(u32x4*)(Wn + 128 * 144) = RA[2];                           \
      if (ks == 3) *(u32x4*)(Wn + 384 * 144) = RB[2];                           \
      acc[1][2] = MFMA(a1, b2, acc[1][2]);                                      \
      acc[1][3] = MFMA(a1, b3, acc[1][3]);                                      \
      if (ks == 2) *(u32x4*)(Wn + 192 * 144) = RA[3];                           \
      if (ks == 3) *(u32x4*)(Wn + 448 * 144) = RB[3];                           \
    }                                                                           \
      \
    __builtin_amdgcn_sched_group_barrier(0x100, 6, 0);                          \
    _Pragma("unroll") for (int q = 0; q < 6; ++q) {                             \
      __builtin_amdgcn_sched_group_barrier(0x008, 1, 0);                        \
      __builtin_amdgcn_sched_group_barrier(0x100, 1, 0);                        \
    }                                                                           \
    __builtin_amdgcn_sched_group_barrier(0x008, 2, 0);                          \
    _Pragma("unroll") for (int q = 0; q < 6; ++q) {                             \
      __builtin_amdgcn_sched_group_barrier(0x008, 1, 0);                        \
      __builtin_amdgcn_sched_group_barrier(0x100, 1, 0);                        \
    }                                                                           \
    __builtin_amdgcn_sched_group_barrier(0x008, 2, 0);                          \
    _Pragma("unroll") for (int q = 0; q < 4; ++q) {                             \
      __builtin_amdgcn_sched_group_barrier(0x008, 1, 0);                        \
      __builtin_amdgcn_sched_group_barrier(0x100, 1, 0);                        \
      __builtin_amdgcn_sched_group_barrier(0x008, 1, 0);                        \
      __builtin_amdgcn_sched_group_barrier(0x200, 1, 0);                        \
    }                                                                           \
    __builtin_amdgcn_sched_group_barrier(0x100, 2, 0);                          \
    _Pragma("unroll") for (int q = 0; q < 4; ++q) {                             \
      __builtin_amdgcn_sched_group_barrier(0x008, 2, 0);                        \
      __builtin_amdgcn_sched_group_barrier(0x200, 1, 0);                        \
    }                                                                           \
  }
  G_LOAD(ra0, rb0, 0);
  G_WRITE(ra0, rb0, 0);
  __syncthreads();
  for (int kt = 0; kt < nk; kt += 2) {
    G_LOAD(ra0, rb0, kt + 1);
    __builtin_amdgcn_sched_barrier(0);
    G_STEP(ra0, rb0, 0);
    __builtin_amdgcn_sched_barrier(0);
    __syncthreads();
    { const int kn = (kt + 2 < nk) ? kt + 2 : nk - 1; G_LOAD(ra0, rb0, kn); }
    __builtin_amdgcn_sched_barrier(0);
    G_STEP(ra0, rb0, 1);
    __builtin_amdgcn_sched_barrier(0);
    __syncthreads();
  }
#undef G_STEP
#undef G_LOAD
#undef G_WRITE
#pragma unroll
  for (int i = 0; i < 2; ++i)
#pragma unroll
    for (int j = 0; j < 4; ++j)
#pragma unroll
      for (int g = 0; g < 4; ++g) {
        const int m = m0 + wm * 64 + i * 32 + 8 * g + 4 * h;
        const int n = n0 + wn * 128 + j * 32 + r32;
        ef(m, n, acc[i][j][4 * g], acc[i][j][4 * g + 1], acc[i][j][4 * g + 2], acc[i][j][4 * g + 3]);
      }
}


constexpr int G8_HT = 128 * 64;
DI int g8_lds_byte(int r, int c) {
  int st = (r >> 4) * 2 + (c >> 5), rr = r & 15, cc = c & 31, ob = rr * 64 + cc * 2;
  return st * 1024 + (ob ^ (((ob >> 9) & 1) << 5));
}
DI void g8_stage_rc(int b, int& R, int& C) {
  int st = b / 1024, sb = b % 1024, swz = sb ^ (((sb >> 9) & 1) << 5);
  R = (st >> 1) * 16 + swz / 64; C = (st & 1) * 32 + (swz % 64) / 2;
}
template <bool SWAP, bool CMP, int NKT = 0, bool WIDE = false, class EF>
DI void gemm8_tile(int wid_s, const u16* __restrict__ A, const u16* __restrict__ Bt, int K, int brow, int bcol, EF ef, char* lds) {
  typedef __attribute__((ext_vector_type(4))) float f32x4;
  u16* shm = (u16*)lds;
  const int tid = TIDX();
#define SA(b, h) (shm + ((b) * 2 + (h)) * G8_HT)
#define SB(b, h) (shm + (4 + (b) * 2 + (h)) * G8_HT)
#define STAGE(P, BASE, br, kt) do { long _g = (long)(br) * K + (long)(kt) * 64; \
    for (int _i = 0; _i < 2; ++_i) { int _b = tid * 16 + _i * 8192; int _r, _c; g8_stage_rc(_b, _r, _c); \
      __builtin_amdgcn_global_load_lds((const unsigned*)(BASE + _g + (long)_r * K + _c), \
        (__attribute__((address_space(3))) unsigned*)((char*)(P) + _b), 16, 0, 0); } } while (0)
#define STAGE_A(P, hsel, kt) do { \
    for (int _i = 0; _i < 2; ++_i) { int _b = tid * 16 + _i * 8192; int _r, _c; g8_stage_rc(_b, _r, _c); \
      const u16* _src = CMP ? (A + (hsel) * 128 + (long)(_r > 126 ? 126 : _r) * (16 * LDKV) + (long)((kt) >> 1) * LDKV + ((kt) & 1) * 64 + _c) \
                            : (A + (long)(brow + (hsel) * 128 + _r) * K + (long)(kt) * 64 + _c); \
      __builtin_amdgcn_global_load_lds((const unsigned*)_src, \
        (__attribute__((address_space(3))) unsigned*)((char*)(P) + _b), 16, 0, 0); } } while (0)
#define LDA(dst, b, h) for (int m = 0; m < 4; ++m) for (int k = 0; k < 2; ++k) \
    dst[m][k] = *reinterpret_cast<const bf16x8*>((char*)SA(b, h) + g8_lds_byte(wr * 64 + m * 16 + fr, k * 32 + fq * 8))
#define LDB(dst, b, h) for (int n = 0; n < 2; ++n) for (int k = 0; k < 2; ++k) \
    dst[n][k] = *reinterpret_cast<const bf16x8*>((char*)SB(b, h) + g8_lds_byte(wc * 32 + n * 16 + fr, k * 32 + fq * 8))
#define MMA(ai, bj, At, Bx) do { __builtin_amdgcn_s_setprio(1); \
    for (int m = 0; m < 4; ++m) for (int n = 0; n < 2; ++n) for (int k = 0; k < 2; ++k) \
      acc[ai][bj][m][n] = SWAP ? __builtin_amdgcn_mfma_f32_16x16x32_bf16(Bx[n][k], At[m][k], acc[ai][bj][m][n], 0, 0, 0) \
                               : __builtin_amdgcn_mfma_f32_16x16x32_bf16(At[m][k], Bx[n][k], acc[ai][bj][m][n], 0, 0, 0); \
    __builtin_amdgcn_s_setprio(0); } while (0)
#define WAIT_V(n) asm volatile("s_waitcnt vmcnt(" #n ")" ::: "memory")
#define WAIT_L(n) asm volatile("s_waitcnt lgkmcnt(" #n ")" ::: "memory")
#define BAR __builtin_amdgcn_s_barrier()
#define SCHED __builtin_amdgcn_sched_barrier(0)
  const int HALF = 128;
  const int wid = wid_s, lane = tid & 63, wr = wid >> 2, wc = wid & 3, fr = lane & 15, fq = lane >> 4;
  f32x4 acc[2][2][4][2] = {};
  bf16x8 At[4][2], B0[2][2], B1[2][2];
  const int nt = NKT ? NKT : K / 64;
  STAGE(SB(0, 0), Bt, bcol, 0); STAGE_A(SA(0, 0), 0, 0);
  STAGE(SB(0, 1), Bt, bcol + HALF, 0); STAGE_A(SA(0, 1), 1, 0);
  if (wr == 1) BAR;
  WAIT_V(4); BAR;
  STAGE(SB(1, 0), Bt, bcol, 1); STAGE_A(SA(1, 0), 0, 1); STAGE(SB(1, 1), Bt, bcol + HALF, 1);
  WAIT_V(6); BAR;
  for (int t = 0; t < nt - 2; t += 2) {
    LDB(B0, 0, 0); SCHED; LDA(At, 0, 0); STAGE_A(SA(1, 1), 1, t + 1);
    WAIT_L(8); BAR; WAIT_L(0); MMA(0, 0, At, B0); BAR; SCHED;
    LDB(B1, 0, 1); STAGE(SB(0, 0), Bt, bcol, t + 2);
    BAR; WAIT_L(0); MMA(0, 1, At, B1); BAR;
    LDA(At, 0, 1); STAGE_A(SA(0, 0), 0, t + 2);
    BAR; WAIT_L(0); MMA(1, 0, At, B0); BAR; SCHED;
    STAGE(SB(0, 1), Bt, bcol + HALF, t + 2);
    WAIT_V(6); BAR; MMA(1, 1, At, B1); BAR;
    LDB(B0, 1, 0); SCHED; LDA(At, 1, 0); STAGE_A(SA(0, 1), 1, t + 2);
    WAIT_L(8); BAR; WAIT_L(0); MMA(0, 0, At, B0); BAR; SCHED;
    LDB(B1, 1, 1); STAGE(SB(1, 0), Bt, bcol, t + 3);
    BAR; WAIT_L(0); MMA(0, 1, At, B1); BAR;
    LDA(At, 1, 1); STAGE_A(SA(1, 0), 0, t + 3);
    BAR; WAIT_L(0); MMA(1, 0, At, B0); BAR; SCHED;
    STAGE(SB(1, 1), Bt, bcol + HALF, t + 3);
    WAIT_V(6); BAR; MMA(1, 1, At, B1); BAR;
  }
  { LDB(B0, 0, 0); LDA(At, 0, 0); STAGE_A(SA(1, 1), 1, nt - 1);
    BAR; WAIT_L(0); MMA(0, 0, At, B0); BAR;
    LDB(B1, 0, 1); BAR; WAIT_L(0); MMA(0, 1, At, B1); BAR;
    LDA(At, 0, 1); WAIT_V(4); BAR; WAIT_L(0); MMA(1, 0, At, B0); MMA(1, 1, At, B1); BAR; }
  { LDB(B0, 1, 0); LDA(At, 1, 0); WAIT_V(2); BAR; WAIT_L(0); MMA(0, 0, At, B0); BAR;
    LDB(B1, 1, 1); WAIT_V(0); BAR; WAIT_L(0); MMA(0, 1, At, B1); BAR;
    LDA(At, 1, 1); BAR; WAIT_L(0); MMA(1, 0, At, B0); MMA(1, 1, At, B1); BAR; }
  if (wr == 0) BAR;
  if constexpr (WIDE) {
    const int cb8 = (fq >> 1) * 8 + (fq & 1) * 16;
    if constexpr (!SWAP) {
#pragma unroll
      for (int ai = 0; ai < 2; ++ai)
#pragma unroll
        for (int bj = 0; bj < 2; ++bj)
#pragma unroll
          for (int mp = 0; mp < 4; mp += 2)
#pragma unroll
            for (int n = 0; n < 2; ++n) {
              const unsigned a0 = pk2(acc[ai][bj][mp][n][0], acc[ai][bj][mp][n][1]), a1 = pk2(acc[ai][bj][mp][n][2], acc[ai][bj][mp][n][3]);
              const unsigned b0 = pk2(acc[ai][bj][mp + 1][n][0], acc[ai][bj][mp + 1][n][1]), b1 = pk2(acc[ai][bj][mp + 1][n][2], acc[ai][bj][mp + 1][n][3]);
              auto r0 = __builtin_amdgcn_permlane16_swap(a0, b0, false, false);
              auto r1 = __builtin_amdgcn_permlane16_swap(a1, b1, false, false);
              u32x4 v = {r0[0], r1[0], r0[1], r1[1]};
              ef(brow + ai * HALF + wr * 64 + mp * 16 + cb8, bcol + bj * HALF + wc * 32 + n * 16 + fr, v);
            }
    } else
#pragma unroll
    for (int ai = 0; ai < 2; ++ai)
#pragma unroll
      for (int bj = 0; bj < 2; ++bj)
#pragma unroll
        for (int m = 0; m < 4; ++m) {
          const unsigned a0 = pk2(acc[ai][bj][m][0][0], acc[ai][bj][m][0][1]), a1 = pk2(acc[ai][bj][m][0][2], acc[ai][bj][m][0][3]);
          const unsigned b0 = pk2(acc[ai][bj][m][1][0], acc[ai][bj][m][1][1]), b1 = pk2(acc[ai][bj][m][1][2], acc[ai][bj][m][1][3]);
          auto r0 = __builtin_amdgcn_permlane16_swap(a0, b0, false, false);
          auto r1 = __builtin_amdgcn_permlane16_swap(a1, b1, false, false);
          u32x4 v = {r0[0], r1[0], r0[1], r1[1]};
          ef(brow + ai * HALF + wr * 64 + m * 16 + fr, bcol + bj * HALF + wc * 32 + cb8, v);
        }
  } else
#pragma unroll
  for (int ai = 0; ai < 2; ++ai)
#pragma unroll
    for (int bj = 0; bj < 2; ++bj)
#pragma unroll
      for (int m = 0; m < 4; ++m)
#pragma unroll
        for (int n = 0; n < 2; ++n)
          if (SWAP)
            ef(brow + ai * HALF + wr * 64 + m * 16 + fr, bcol + bj * HALF + wc * 32 + n * 16 + fq * 4,
               acc[ai][bj][m][n][0], acc[ai][bj][m][n][1], acc[ai][bj][m][n][2], acc[ai][bj][m][n][3]);
          else
            ef(brow + ai * HALF + wr * 64 + m * 16 + fq * 4, bcol + bj * HALF + wc * 32 + n * 16 + fr,
               acc[ai][bj][m][n][0], acc[ai][bj][m][n][1], acc[ai][bj][m][n][2], acc[ai][bj][m][n][3]);
#undef SA
#undef SB
#undef STAGE
#undef STAGE_A
#undef LDA
#undef LDB
#undef MMA
#undef WAIT_V
#undef WAIT_L
#undef BAR
#undef SCHED
}

DI void tile_order(int idx, int MT, int NT, int& mt, int& nt) {
  const int per_ng = MT * 8;
  const int ng = idx / per_ng;
  const int rem = idx - ng * per_ng;
  int gn = NT - ng * 8; if (gn > 8) gn = 8;
  const int per_mg = 32 * gn;
  const int mg = rem / per_mg;
  const int r2 = rem - mg * per_mg;
  nt = ng * 8 + (r2 >> 5);
  mt = mg * 32 + (r2 & 31);
}

DI void load_q(const u16* __restrict__ q0, long ldq, const float* __restrict__ gain, float mult, char* st, int lane, bf16x8 (&qr)[8]) {
  const int r32 = lane & 31, h = lane >> 5, er = lane >> 4, ec = lane & 15;
#pragma unroll
  for (int j = 0; j < 8; ++j) {
    const int rr = j * 4 + er;
    *(uint4*)(st + rr * 272 + ec * 16) = *(const uint4*)(q0 + (long)rr * ldq + ec * 8);
  }
  uint4 raw[8];
  float ss = 0.f;
#pragma unroll
  for (int d0 = 0; d0 < 8; ++d0) raw[d0] = *(const uint4*)(st + r32 * 272 + (16 * d0 + 8 * h) * 2);
#pragma unroll
  for (int d0 = 0; d0 < 8; ++d0) {
    float f[8];
    unpack8(raw[d0], f);
#pragma unroll
    for (int j = 0; j < 8; ++j) ss += f[j] * f[j];
  }
  ss = xor32_sum(ss);
  const float rs = rsqrtf(ss * (1.f / 128.f) + EPS) * mult;
#pragma unroll
  for (int d0 = 0; d0 < 8; ++d0) {
    float f[8];
    unpack8(raw[d0], f);
    float4 ga = *(const float4*)(gain + 16 * d0 + 8 * h), gb = *(const float4*)(gain + 16 * d0 + 8 * h + 4);
    u32x4 w;
    w[0] = pk2(f[0] * rs * ga.x, f[1] * rs * ga.y);
    w[1] = pk2(f[2] * rs * ga.z, f[3] * rs * ga.w);
    w[2] = pk2(f[4] * rs * gb.x, f[5] * rs * gb.y);
    w[3] = pk2(f[6] * rs * gb.z, f[7] * rs * gb.w);
    qr[d0] = __builtin_bit_cast(bf16x8, w);
  }
}

template <class VF, class AF, class FF>
DI void attn_loop(int wid_s, const bf16x8 (&qr)[8], const u16* __restrict__ Kb, long ldk, const u16* __restrict__ Vt, long ldv,
                  int kt0, int kt1, VF validf, AF activef, FF fullf, f32x16 (&o)[4], float& m_run, float& l_run, char* lds) {
  const int tid = TIDX(), lane = tid & 63, r32 = lane & 31, h = lane >> 5;
  const int lrow = tid >> 4, lch = tid & 15;
  u32x4 rk[4], rv[4];
#define A_GLOAD(KP)                                                                                   \
  _Pragma("unroll") for (int i = 0; i < 4; ++i) {                                                     \
    rk[i] = *(const u32x4*)(Kb + (long)((KP) * 128 + lrow + 32 * i) * ldk + lch * 8);                 \
    rv[i] = *(const u32x4*)(Vt + (long)(lrow + 32 * i) * ldv + (KP) * 128 + lch * 8);                 \
  }
#define A_SWRITE(BUF)                                                                                 \
  _Pragma("unroll") for (int i = 0; i < 4; ++i) {                                                     \
    *(u32x4*)(lds + (BUF) * ATT_BUF + (lrow + 32 * i) * 272 + lch * 16) = rk[i];                      \
    char* vg = lds + (BUF) * ATT_BUF + 128 * 272 + (lrow + 32 * i) * 272 + (lch >> 1) * 32 + (lch & 1) * 8; \
    *(uint2*)vg = make_uint2(rv[i][0], rv[i][1]);                                                     \
    *(uint2*)(vg + 16) = make_uint2(rv[i][2], rv[i][3]);                                              \
  }
  const int kp0 = kt0 >> 1, kp1 = kt1 >> 1;
  A_GLOAD(kp0);
  A_SWRITE(0);
  __syncthreads();
  for (int kp = kp0; kp < kp1; ++kp) {
    const int cur = (kp - kp0) & 1;
    if (kp + 1 < kp1) { A_GLOAD(kp + 1); }
#pragma unroll
    for (int t = 0; t < 2; ++t) {
      const int kt = kp * 2 + t;
      const char* Ks = lds + cur * ATT_BUF + t * 64 * 272;
      const char* Vs = lds + cur * ATT_BUF + 128 * 272 + t * 128;
      if (activef(kt)) {
        f32x16 p0, p1;
#pragma unroll
        for (int r = 0; r < 16; ++r) { p0[r] = 0.f; p1[r] = 0.f; }
        __builtin_amdgcn_s_setprio(1);
#pragma unroll
        for (int d0 = 0; d0 < 8; ++d0) {
          bf16x8 a0 = *(const bf16x8*)(Ks + r32 * 272 + (16 * d0 + 8 * h) * 2);
          bf16x8 a1 = *(const bf16x8*)(Ks + (32 + r32) * 272 + (16 * d0 + 8 * h) * 2);
          p0 = MFMA(a0, qr[d0], p0);
          p1 = MFMA(a1, qr[d0], p1);
        }
        __builtin_amdgcn_s_setprio(0);
        if (!fullf(kt)) {
#pragma unroll
          for (int r = 0; r < 16; ++r) {
            p0[r] = validf(kt * 64 + crow(r, h), kt) ? p0[r] : -1e30f;
            p1[r] = validf(kt * 64 + 32 + crow(r, h), kt) ? p1[r] : -1e30f;
          }
        }
        float mx = m_run;
#pragma unroll
        for (int r = 0; r < 16; ++r) mx = fmaxf(mx, fmaxf(p0[r], p1[r]));
        const float mn = xor32_max(mx);
        const float alpha = __builtin_amdgcn_exp2f(m_run - mn);
        m_run = mn;
        float sum = 0.f;
#pragma unroll
        for (int r = 0; r < 16; ++r) {
          p0[r] = __builtin_amdgcn_exp2f(p0[r] - mn);
          p1[r] = __builtin_amdgcn_exp2f(p1[r] - mn);
          sum += p0[r] + p1[r];
        }
        sum = xor32_sum(sum);
        l_run = l_run * alpha + sum;
#pragma unroll
        for (int d0 = 0; d0 < 4; ++d0)
#pragma unroll
          for (int r = 0; r < 16; ++r) o[d0][r] *= alpha;
#pragma unroll
        for (int kb = 0; kb < 2; ++kb) {
#pragma unroll
          for (int s = 0; s < 2; ++s) {
            u32x4 w;
            if (kb == 0) {
              w[0] = pk2(p0[8 * s + 0], p0[8 * s + 1]); w[1] = pk2(p0[8 * s + 2], p0[8 * s + 3]);
              w[2] = pk2(p0[8 * s + 4], p0[8 * s + 5]); w[3] = pk2(p0[8 * s + 6], p0[8 * s + 7]);
            } else {
              w[0] = pk2(p1[8 * s + 0], p1[8 * s + 1]); w[1] = pk2(p1[8 * s + 2], p1[8 * s + 3]);
              w[2] = pk2(p1[8 * s + 4], p1[8 * s + 5]); w[3] = pk2(p1[8 * s + 6], p1[8 * s + 7]);
            }
            const bf16x8 xs = __builtin_bit_cast(bf16x8, w);
#pragma unroll
            for (int d0 = 0; d0 < 4; ++d0) {
              const bf16x8 a = *(const bf16x8*)(Vs + (32 * d0 + r32) * 272 + (2 * kb + s) * 32 + h * 16);
              o[d0] = MFMA(a, xs, o[d0]);
            }
          }
        }
      }
    }
    if (kp + 1 < kp1) { A_SWRITE(cur ^ 1); }
    __syncthreads();
  }
#undef A_GLOAD
#undef A_SWRITE
}


DI void stage_o(const f32x16 (&o)[4], float scale, char* st, int r32, int h) {
#pragma unroll
  for (int d0 = 0; d0 < 4; ++d0)
#pragma unroll
    for (int g = 0; g < 4; ++g) {
      uint2 w;
      w.x = pk2(o[d0][4 * g] * scale, o[d0][4 * g + 1] * scale);
      w.y = pk2(o[d0][4 * g + 2] * scale, o[d0][4 * g + 3] * scale);
      *(uint2*)(st + r32 * 272 + (32 * d0 + 8 * g + 4 * h) * 2) = w;
    }
}

DI void mem_attn_item(int wid_s, int it, const u16* __restrict__ Qsrc, long ldq, int qoff, int zoff, const float* __restrict__ qgain,
                      const u16* __restrict__ memK, const u16* __restrict__ memVt, u16* __restrict__ Y, char* lds) {
  const int tid = TIDX(), lane = tid & 63, wid = wid_s, r32 = lane & 31, h = lane >> 5;
  const int qt = it & 7, hm = (it >> 3) & 3, b = it >> 5;
  const int s = qt * 256 + wid * 32 + r32;
  const long row = (long)b * SEQ + s;
  bf16x8 qr[8];
  load_q(Qsrc + ((long)b * SEQ + qt * 256 + wid * 32) * ldq + qoff + hm * 128, ldq, qgain, QMULT, lds + ATT_BUF + wid * STG_WAVE, lane, qr);
  f32x16 o[4];
#pragma unroll
  for (int d0 = 0; d0 < 4; ++d0)
#pragma unroll
    for (int r = 0; r < 16; ++r) o[d0][r] = 0.f;
  float m_run = -1e20f, l_run = 0.f;
  attn_loop(wid_s, qr, memK + (long)(b * 4 + hm) * 256 * 128, 128, memVt + (long)(b * 4 + hm) * 128 * 256, 256, 0, 4,
            [](int, int) { return true; }, [](int) { return true; }, [](int) { return true; }, o, m_run, l_run, lds);
  const float inv = l_run > 0.f ? 1.f / l_run : 0.f;
  char* st = lds + ATT_BUF + wid * STG_WAVE;
  const int tid2 = TIDX();
  const int lane2 = tid2 & 63;
  stage_o(o, inv, st, lane2 & 31, lane2 >> 5);
  const long row0 = (long)b * SEQ + qt * 256 + wid * 32;
  const int er = lane2 >> 4, ec = lane2 & 15;
#pragma unroll
  for (int j = 0; j < 8; ++j) {
    const int rr = j * 4 + er;
    float f[8], z[8];
    unpack8(*(const uint4*)(st + rr * 272 + ec * 16), f);
    unpack8(*(const uint4*)(Qsrc + (row0 + rr) * ldq + zoff + hm * 128 + ec * 8), z);
#pragma unroll
    for (int e = 0; e < 8; ++e) f[e] *= silu_f(z[e]);
    *(uint4*)(Y + (row0 + rr) * 2048 + 1536 + hm * 128 + ec * 8) = pack8(f);
  }
}

template <int MODE>
DI void nsa_attn_item(int wid_s, int it, const Params& p, char* lds) {
  const int tid = TIDX(), lane = tid & 63, wid = wid_s, r32 = lane & 31, h = lane >> 5;
  const u16* QG = (const u16*)(p.ws + OFF_QG);
  const u16* KV = (const u16*)(p.ws + OFF_KV);
  u16* Osum = (u16*)(p.ws + OFF_OSUM);
  int qt, b, head;
  if (gridDim.x == 256) {
    const int blk = it & 255, rnd = it >> 8;
    const int slot = (rnd & 1) ? 31 - (blk >> 3) : (blk >> 3);
    const int idx = rnd * 32 + slot;
    qt = 7 - idx / 24;
    const int rem = idx % 24, pg = (blk & 7) * 8 + rem / 3;
    b = pg >> 2;
    head = (pg & 3) * 3 + rem % 3;
  } else {
    qt = 7 - (it / 192);
    const int r = it % 192;
    head = r % 12; b = r / 12;
  }
  const int g = head / 3;
  const int s0w = qt * 256 + wid * 32;
  const int tq = s0w + r32;
  const long row = (long)b * SEQ + tq;
  bf16x8 qr[8];
  load_q(QG + ((long)b * SEQ + s0w) * LDQG + head * 128, LDQG, p.b_q_norm, QMULT, lds + ATT_BUF + wid * STG_WAVE, lane, qr);
  f32x16 o[4];
#pragma unroll
  for (int d0 = 0; d0 < 4; ++d0)
#pragma unroll
    for (int rr = 0; rr < 16; ++rr) o[d0][rr] = 0.f;
  float m_run = -1e20f, l_run = 0.f;
  if (MODE == 0) {
    const u16* Kb = KV + (long)b * SEQ * LDKV + 2048 + g * 128;
    const u16* Vt = (const u16*)(p.ws + OFF_VTW) + (long)(b * 4 + g) * 128 * SEQ;
    int kt0 = qt * 4 - 8; if (kt0 < 0) kt0 = 0;
    const int kt1 = qt * 4 + 4;
    attn_loop(wid_s, qr, Kb, LDKV, Vt, SEQ, kt0, kt1,
              [=](int key, int) { const int diff = tq - key; return diff >= 0 && diff < 512; },
              [=](int kt) { return (kt * 64 <= s0w + 31) && (kt * 64 + 63 >= s0w - 511); },
              [=](int kt) { return (kt * 64 + 63 <= s0w) && (kt * 64 >= s0w - 480); }, o, m_run, l_run, lds);
  } else {
    const u16* Kb = KV + (long)b * SEQ * LDKV + 1024 + g * 128;
    const u16* Vt = (const u16*)(p.ws + OFF_VTS) + (long)(b * 4 + g) * 128 * SEQ;
    const unsigned sel = ((const unsigned*)(p.ws + OFF_SEL))[(long)(b * 4 + g) * SEQ + tq];
    const int kt1 = qt * 4 + 4;
    attn_loop(wid_s, qr, Kb, LDKV, Vt, SEQ, 0, kt1,
              [=](int key, int kt) { return (key <= tq) && ((sel >> kt) & 1u); },
              [=](int kt) { return (kt * 64 <= s0w + 31) && (__ballot((sel >> kt) & 1u) != 0ull); },
              [=](int kt) { return (kt * 64 + 63 <= s0w) && (__ballot((sel >> kt) & 1u) == ~0ull); }, o, m_run, l_run, lds);
  }
  const float inv = l_run > 0.f ? 1.f / l_run : 0.f;
  const int gidx = head * 3 + (MODE == 0 ? 2 : 1);
  const int tid2 = TIDX();
  const int lane2 = tid2 & 63, r32b = lane2 & 31, hb = lane2 >> 5;
  const long row0 = (long)b * SEQ + s0w;
  const float gl = bflo((unsigned)QG[(row0 + r32b) * LDQG + 4096 + gidx]);
  const float gate = sigmoid_f(gl + p.b_gate_bias[gidx]) * inv;
  char* st = lds + ATT_BUF + wid * STG_WAVE;
  stage_o(o, gate, st, r32b, hb);
  const int er = lane2 >> 4, ec = lane2 & 15;
  if (MODE == 0) {
#pragma unroll
    for (int j = 0; j < 8; ++j) {
      const int rr = j * 4 + er;
      *(uint4*)(Osum + (row0 + rr) * 1536 + head * 128 + ec * 8) = *(const uint4*)(st + rr * 272 + ec * 16);
    }
  } else {
    u16* Y2 = (u16*)(p.ws + OFF_Y2);
#pragma unroll
    for (int j = 0; j < 8; ++j) {
      const int rr = j * 4 + er;
      float f[8], z[8], os[8], oc[8];
      u16* yp = Y2 + (row0 + rr) * 2048 + head * 128 + ec * 8;
      unpack8(*(const uint4*)(st + rr * 272 + ec * 16), f);
      unpack8(*(const uint4*)(QG + (row0 + rr) * LDQG + 1536 + head * 128 + ec * 8), z);
      unpack8(*(const uint4*)(Osum + (row0 + rr) * 1536 + head * 128 + ec * 8), os);
      unpack8(*(const uint4*)yp, oc);
#pragma unroll
      for (int e = 0; e < 8; ++e) f[e] = (os[e] + oc[e] + f[e]) * silu_f(z[e]);
      *(uint4*)yp = pack8(f);
    }
  }
}

DI void cmp_item(int wid_s, int it, const Params& p, char* lds) {
  const int tid = TIDX(), lane = tid & 63, wid = wid_s, r32 = lane & 31, h = lane >> 5;
  const u16* QG = (const u16*)(p.ws + OFF_QG);
  const u16* Kc = (const u16*)(p.ws + OFF_KC);
  const u16* Vct = (const u16*)(p.ws + OFF_VCT);
  u16* Osum = (u16*)(p.ws + OFF_OSUM);
  const int qt = it & 7, g = (it >> 3) & 3, b = it >> 5;
  const int bg = b * 4 + g;
  char* Ks = lds;
  char* Vs = lds + 128 * 272;
  {
    const int r0 = tid >> 4, ch = tid & 15;
    float4 ga = *(const float4*)(p.kn_cmp + ch * 8), gb = *(const float4*)(p.kn_cmp + ch * 8 + 4);
#pragma unroll
    for (int i = 0; i < 4; ++i) {
      const int rr = r0 + 32 * i;
      uint4 v = *(const uint4*)(Kc + ((long)bg * 128 + rr) * 128 + ch * 8);
      float f[8];
      unpack8(v, f);
      float ss = 0.f;
#pragma unroll
      for (int j = 0; j < 8; ++j) ss += f[j] * f[j];
      ss += __shfl_xor(ss, 1); ss += __shfl_xor(ss, 2); ss += __shfl_xor(ss, 4); ss += __shfl_xor(ss, 8);
      const float rs = rsqrtf(ss * (1.f / 128.f) + EPS);
      f[0] *= rs * ga.x; f[1] *= rs * ga.y; f[2] *= rs * ga.z; f[3] *= rs * ga.w;
      f[4] *= rs * gb.x; f[5] *= rs * gb.y; f[6] *= rs * gb.z; f[7] *= rs * gb.w;
      *(uint4*)(Ks + rr * 272 + ch * 16) = pack8(f);
      u32x4 vv = *(const u32x4*)(Vct + ((long)bg * 128 + rr) * 128 + ch * 8);
      {
        char* vg = Vs + rr * 272 + (ch >> 1) * 32 + (ch & 1) * 8;
        *(uint2*)vg = make_uint2(vv[0], vv[1]);
        *(uint2*)(vg + 16) = make_uint2(vv[2], vv[3]);
      }
    }
  }
  __syncthreads();
  const int tq = qt * 256 + wid * 32 + r32;
  const long row = (long)b * SEQ + tq;
  float gs[16], last[16];
#pragma unroll
  for (int i = 0; i < 16; ++i) { gs[i] = 0.f; last[i] = 0.f; }
#pragma unroll 1
  for (int j = 0; j < 3; ++j) {
    asm volatile("" ::: "memory");
    const int head = g * 3 + j;
    bf16x8 qr[8];
    load_q(QG + ((long)b * SEQ + qt * 256 + wid * 32) * LDQG + head * 128, LDQG, p.b_q_norm, QMULT, lds + 2 * 128 * 272 + wid * STG_WAVE, lane, qr);
    f32x16 pp[4];
#pragma unroll
    for (int kb = 0; kb < 4; ++kb)
#pragma unroll
      for (int r = 0; r < 16; ++r) pp[kb][r] = 0.f;
#pragma unroll
    for (int d0 = 0; d0 < 8; ++d0) {
#pragma unroll
      for (int kb = 0; kb < 4; ++kb) {
        bf16x8 a = *(const bf16x8*)(Ks + (32 * kb + r32) * 272 + (16 * d0 + 8 * h) * 2);
        pp[kb] = MFMA(a, qr[d0], pp[kb]);
      }
    }
    float mx = -1e30f;
#pragma unroll
    for (int kb = 0; kb < 4; ++kb)
#pragma unroll
      for (int r = 0; r < 16; ++r) {
        const int c = 32 * kb + crow(r, h);
        const bool v = (16 * c + 31 <= tq);
        mx = v ? fmaxf(mx, pp[kb][r]) : mx;
      }
    mx = xor32_max(mx);
    float sum = 0.f;
#pragma unroll
    for (int kb = 0; kb < 4; ++kb)
#pragma unroll
      for (int r = 0; r < 16; ++r) {
        const int c = 32 * kb + crow(r, h);
        const bool v = (16 * c + 31 <= tq);
        pp[kb][r] = v ? __builtin_amdgcn_exp2f(pp[kb][r] - mx) : 0.f;
        sum += pp[kb][r];
      }
    sum = xor32_sum(sum);
    const float inv = sum > 0.f ? 1.f / sum : 0.f;
#pragma unroll
    for (int kb = 0; kb < 4; ++kb)
#pragma unroll
      for (int r = 0; r < 16; ++r) pp[kb][r] *= inv;
#pragma unroll
    for (int kb = 0; kb < 4; ++kb)
#pragma unroll
      for (int g4 = 0; g4 < 4; ++g4) {
        gs[kb * 4 + g4] += pp[kb][4 * g4] + pp[kb][4 * g4 + 1] + pp[kb][4 * g4 + 2] + pp[kb][4 * g4 + 3];
        last[kb * 4 + g4] += pp[kb][4 * g4 + 3];
      }
    bf16x8 xs[8];
#pragma unroll
    for (int kb = 0; kb < 4; ++kb)
#pragma unroll
      for (int s = 0; s < 2; ++s) {
        u32x4 w;
        w[0] = pk2(pp[kb][8 * s + 0], pp[kb][8 * s + 1]); w[1] = pk2(pp[kb][8 * s + 2], pp[kb][8 * s + 3]);
        w[2] = pk2(pp[kb][8 * s + 4], pp[kb][8 * s + 5]); w[3] = pk2(pp[kb][8 * s + 6], pp[kb][8 * s + 7]);
        xs[kb * 2 + s] = __builtin_bit_cast(bf16x8, w);
      }
    f32x16 o[4];
#pragma unroll
    for (int d0 = 0; d0 < 4; ++d0)
#pragma unroll
      for (int r = 0; r < 16; ++r) o[d0][r] = 0.f;
#pragma unroll
    for (int ks = 0; ks < 8; ++ks) {
#pragma unroll
      for (int d0 = 0; d0 < 4; ++d0) {
        const bf16x8 a = *(const bf16x8*)(Vs + (32 * d0 + r32) * 272 + ks * 32 + h * 16);
        o[d0] = MFMA(a, xs[ks], o[d0]);
      }
    }
    const int gidx = head * 3;
    const float gl = bflo((unsigned)QG[row * LDQG + 4096 + gidx]);
    const float gate = sigmoid_f(gl + p.b_gate_bias[gidx]);
    {
      char* st = lds + 2 * 128 * 272 + wid * STG_WAVE;
      stage_o(o, gate, st, r32, h);
      const long row0 = (long)b * SEQ + qt * 256 + wid * 32;
      const int er = lane >> 4, ec = lane & 15;
      u16* Oc = (u16*)(p.ws + OFF_Y2);
#pragma unroll
      for (int jj = 0; jj < 8; ++jj) {
        const int rr = jj * 4 + er;
        *(uint4*)(Oc + (row0 + rr) * 2048 + head * 128 + ec * 8) = *(const uint4*)(st + rr * 272 + ec * 16);
      }
    }
  }
  float sc_own[16];
#pragma unroll
  for (int i = 0; i < 16; ++i) {
    const float pl = xor32_get(last[i], h);
    float prev;
    if (i > 0) {
      const float plm = xor32_get(last[i - 1], h);
      prev = h ? pl : plm;
    } else {
      prev = h ? pl : 0.f;
    }
    sc_own[i] = gs[i] + prev;
  }
  __syncthreads();
  float* sbuf = (float*)lds;
#pragma unroll
  for (int i = 0; i < 16; ++i) sbuf[(wid * 32 + r32) * 33 + 2 * i + h] = sc_own[i];
  __syncthreads();
  float msc[32];
  const int cur = tq >> 6;
#pragma unroll
  for (int jj = 0; jj < 32; ++jj) {
    float v = sbuf[(wid * 32 + r32) * 33 + jj];
    if (jj == 0 || jj == cur || jj == cur - 1) v = 1e4f;
    else if (jj > cur) v = -1e30f;
    msc[jj] = v;
  }
  unsigned mask = 0;
#pragma unroll
  for (int jj = 0; jj < 32; ++jj) {
    int rank = 0;
#pragma unroll
    for (int j2 = 0; j2 < 32; ++j2) {
      if (j2 < jj) rank += (msc[j2] >= msc[jj]) ? 1 : 0;
      else if (j2 > jj) rank += (msc[j2] > msc[jj]) ? 1 : 0;
    }
    if (rank < 16 && jj <= cur) mask |= 1u << jj;
  }
  if (h == 0) ((unsigned*)(p.ws + OFF_SEL))[(long)bg * SEQ + tq] = mask;
  __syncthreads();
}

DI void grid_barrier(int wid_s, unsigned* ctr, unsigned target) {
  __syncthreads();
  if (wid_s == 0) {
    const int lane = (int)__builtin_amdgcn_mbcnt_hi(~0u, __builtin_amdgcn_mbcnt_lo(~0u, 0u));
    if (lane == 0) {
      __atomic_thread_fence(__ATOMIC_RELEASE);
      asm volatile("s_waitcnt vmcnt(0) lgkmcnt(0)" ::: "memory");
      __hip_atomic_fetch_add(ctr, 1u, __ATOMIC_RELAXED, __HIP_MEMORY_SCOPE_AGENT);
      while (__hip_atomic_load(ctr, __ATOMIC_RELAXED, __HIP_MEMORY_SCOPE_AGENT) < target) __builtin_amdgcn_s_sleep(2);
      __atomic_thread_fence(__ATOMIC_ACQUIRE);
      asm volatile("s_waitcnt vmcnt(0) lgkmcnt(0)" ::: "memory");
    }
  }
  __syncthreads();
}

#define P_WA_IN ((u16*)(p.ws + OFF_WA_IN))
#define P_WA_OUT ((u16*)(p.ws + OFF_WA_OUT))
#define P_WKV ((u16*)(p.ws + OFF_WKV))
#define P_WB_IN ((u16*)(p.ws + OFF_WB_IN))
#define P_WB_OUT ((u16*)(p.ws + OFF_WB_OUT))
#define P_WMEM ((u16*)(p.ws + OFF_WMEM))
#define P_W1T ((u16*)(p.ws + OFF_W1))
#define P_W2T ((u16*)(p.ws + OFF_W2))
#define P_MEMH ((u16*)(p.ws + OFF_MEMH))
#define P_MEMK ((u16*)(p.ws + OFF_MEMK))
#define P_MEMVT ((u16*)(p.ws + OFF_MEMVT))
#define P_HID ((u16*)(p.ws + OFF_HID))
#define P_KC ((u16*)(p.ws + OFF_KC))
#define P_VCT ((u16*)(p.ws + OFF_VCT))
#define P_H1 ((u16*)(p.ws + OFF_H1))
#define P_Y1 ((u16*)(p.ws + OFF_H1))
#define P_VTS ((u16*)(p.ws + OFF_VTS))
#define P_VTW ((u16*)(p.ws + OFF_VTW))
#define P_U ((u16*)(p.ws + OFF_U))
#define P_HKV ((u16*)(p.ws + OFF_HKV))
#define P_HB ((u16*)(p.ws + OFF_HB))
#define P_KV ((u16*)(p.ws + OFF_KV))
#define P_Y2 ((u16*)(p.ws + OFF_Y2))
#define P_QG ((u16*)(p.ws + OFF_QG))
#define P_BIASP ((float*)(p.ws + OFF_BIASP))
#define P_BIAS ((float*)(p.ws + OFF_BIAS))
__global__ void __launch_bounds__(512) mega(Params p) {
  extern __shared__ __attribute__((aligned(16))) char lds[];
  cg::grid_group grid = cg::this_grid();
  const int G = gridDim.x;
  const int wid_s = __builtin_amdgcn_readfirstlane((int)threadIdx.x >> 6);
  if (blockIdx.x == 0 && wid_s == 0) {
    if (TIDX() == 0) __hip_atomic_store((unsigned*)(p.ws + OFF_BAR), 0u, __ATOMIC_RELAXED, __HIP_MEMORY_SCOPE_AGENT);
  }
  for (int rep = 0; rep < PROBE_M; ++rep) {
    const int TOTAL = 2708;
    for (int t = blockIdx.x; t < TOTAL; t += G) {
      int r = t;
      const float* src; u16* dst; int K, Nsrc, mode = 0; const float* kgain = nullptr;
      if (r < 896) { src = p.a_w_in; dst = P_WA_IN; K = 2048; Nsrc = 7168; }
      else if ((r -= 896) < 256) { src = p.a_w_out; dst = P_WA_OUT; K = 2048; Nsrc = 2048; }
      else if ((r -= 256) < 384) { src = p.kv_w; dst = P_WKV; K = 2048; Nsrc = 3072; kgain = p.kv_norm; }
      else if ((r -= 384) < 528) { src = p.b_w_in; dst = P_WB_IN; K = 2048; Nsrc = 4132; mode = 1; kgain = p.b_norm; }
      else if ((r -= 528) < 256) { src = p.b_w_out; dst = P_WB_OUT; K = 2048; Nsrc = 2048; }
      else if ((r -= 256) < 128) { src = p.mem_w_kv; dst = P_WMEM; K = 2048; Nsrc = 1024; kgain = p.mem_norm; }
      else if ((r -= 128) < 128) { src = p.mem_w_kv + 2048 * 1024; dst = P_WMEM + 1024 * 2048; K = 2048; Nsrc = 1024; kgain = p.mem_norm + 2048; }
      else if ((r -= 128) < 64) { src = p.cmp_w1_k; dst = P_W1T; K = 4096; Nsrc = 256; }
      else if ((r -= 64) < 64) { src = p.cmp_w1_v; dst = P_W1T + 256 * 4096; K = 4096; Nsrc = 256; }
      else if ((r -= 64) < 2) { src = p.cmp_w2_k; dst = P_W2T; K = 256; Nsrc = 128; }
      else { r -= 2; src = p.cmp_w2_v; dst = P_W2T + 128 * 256; K = 256; Nsrc = 128; }
      const int nkt = K >> 8;
      transpose_tile(wid_s, src, Nsrc, dst, K, r % nkt, r / nkt, mode, kgain, lds);
    }
    rmsnorm_rows(wid_s, p.x, T, p.a_norm, P_H1, nullptr, nullptr);
    rmsnorm_rows(wid_s, p.mem, 4096, nullptr, P_MEMH, nullptr, nullptr);
    for (int it = blockIdx.x; it < 32; it += G) {
      const int tid = TIDX();
      const int mat = it >> 4, chunk = (it & 15) * 2 + (tid >> 8), f = tid & 255;
      const float* pos = mat ? p.cmp_pos_v : p.cmp_pos_k;
      const float* w1 = mat ? p.cmp_w1_v : p.cmp_w1_k;
      float acc = 0.f;
      for (int k = chunk * 128; k < chunk * 128 + 128; ++k) acc += pos[k] * w1[(long)k * 256 + f];
      P_BIASP[(mat * 32 + chunk) * 256 + f] = acc;
    }
  }
  grid.sync();

  {
    const int NU = 128 * 28;
    for (int rep = 0; rep < PROBE_G; ++rep)
    for (int it = blockIdx.x; it < NU + 128; it += G) {
      if (it < NU) {
        int mt, nt;
        tile_order(it, 128, 28, mt, nt);
        gemm8_tile<true, false, 0, true>(wid_s, P_H1, P_WA_IN, 2048, mt * 256, nt * 256,
                  [=](int m, int n, u32x4 v) { *(u32x4*)(P_U + (long)m * LDU + n) = v; }, lds);
      } else {
        const int it2 = it - NU;
        const int l = it2 >> 6, rr = it2 & 63, mt = rr & 15, nt = rr >> 4;
        const u16* A = P_MEMH;
        u16* mk = P_MEMK + (long)l * 16 * 4 * 256 * 128;
        u16* mv = P_MEMVT + (long)l * 16 * 4 * 256 * 128;
        gemm8_tile<false, false>(wid_s, A, P_WMEM + (long)l * 1024 * 2048, 2048, mt * 256, nt * 256,
                  [=](int m, int n, float v0, float v1, float v2, float v3) {
                    const int b = m >> 8, mtok = m & 255;
                    const unsigned a = pk2(v0, v1), bb = pk2(v2, v3);
                    if (n < 512) {
                      const int hm = n >> 7, d = n & 127;
                      u16* c = mk + ((long)(b * 4 + hm) * 256 + mtok) * 128 + d;
                      c[0] = (u16)a; c[128] = (u16)(a >> 16); c[256] = (u16)bb; c[384] = (u16)(bb >> 16);
                    } else {
                      const int hm = (n - 512) >> 7, d = n & 127;
                      uint2 w; w.x = a; w.y = bb;
                      *(uint2*)(mv + ((long)(b * 4 + hm) * 128 + d) * 256 + mtok) = w;
                    }
                  }, lds);
      }
    }
  }
  grid_barrier(wid_s, (unsigned*)(p.ws + OFF_BAR), 1u * (unsigned)G);

  {
    rownorm128(wid_s, P_MEMK, 128, 0, 16384, p.mem_k_norm);
    rownorm128(wid_s, P_MEMK + 16384 * 128, 128, 0, 16384, p.mem_k_norm + 128);
    for (int rep = 0; rep < PROBE_M; ++rep) conv_pass(wid_s, P_U, p.a_conv_w, p.a_conv_b, P_Y1);
    if (blockIdx.x == 0) {
      const int tid = TIDX();
      {
        const int f = tid;
        float a = 0.f;
        for (int c = 0; c < 32; ++c) a += P_BIASP[((f >> 8) * 32 + c) * 256 + (f & 255)];
        P_BIAS[f] = a;
      }
    }
  }
  grid_barrier(wid_s, (unsigned*)(p.ws + OFF_BAR), 2u * (unsigned)G);

  for (int rep = 0; rep < PROBE_A; ++rep)
  for (int it = blockIdx.x; it < 512; it += G)
    mem_attn_item(wid_s, it, P_U, LDU, 6144, 6656, p.mem_q_norm, P_MEMK, P_MEMVT, P_Y1, lds);
  grid_barrier(wid_s, (unsigned*)(p.ws + OFF_BAR), 3u * (unsigned)G);

  for (int rep = 0; rep < PROBE_G; ++rep)
  for (int it = blockIdx.x; it < 128 * 8; it += G) {
    int mt, nt;
    tile_order(it, 128, 8, mt, nt);
    const float* xin = p.x; float* xo = p.out;
    gemm8_tile<true, false>(wid_s, P_Y1, P_WA_OUT, 2048, mt * 256, nt * 256,
              [=](int m, int n, float v0, float v1, float v2, float v3) {
                const long o = (long)m * 2048 + n;
                float4 r = *(const float4*)(xin + o);
                r.x += v0; r.y += v1; r.z += v2; r.w += v3;
                *(float4*)(xo + o) = r;
              }, lds);
  }
  grid_barrier(wid_s, (unsigned*)(p.ws + OFF_BAR), 4u * (unsigned)G);

  for (int rep = 0; rep < PROBE_M; ++rep) rmsnorm_rows(wid_s, p.out, T, nullptr, P_HKV, nullptr, nullptr);
  grid_barrier(wid_s, (unsigned*)(p.ws + OFF_BAR), 5u * (unsigned)G);

  {
    const int NKV = 128 * 12, NQG = 128 * 17;
    for (int rep = 0; rep < PROBE_G; ++rep)
    for (int it = blockIdx.x; it < NKV + NQG; it += G) {
      if (it < NKV) {
        int mt, nt;
        tile_order(it, 128, 12, mt, nt);
        const int sec = nt >> 1;
        if (sec == 3 || sec == 5) {
          u16* vt = (sec == 3) ? P_VTS : P_VTW;
          gemm8_tile<false, false, 0, true>(wid_s, P_HKV, P_WKV, 2048, mt * 256, nt * 256,
                    [=](int m, int n, u32x4 v) {
                      const int gk = (n & 511) >> 7, d = n & 127, bb = m >> 11, s = m & 2047;
                      *(u32x4*)(vt + ((long)(bb * 4 + gk) * 128 + d) * SEQ + s) = v;
                    }, lds);
        } else {
          gemm8_tile<true, false, 0, true>(wid_s, P_HKV, P_WKV, 2048, mt * 256, nt * 256,
                    [=](int m, int n, u32x4 v) { *(u32x4*)(P_KV + (long)m * LDKV + n) = v; }, lds);
        }
      } else {
        int mt, nt;
        tile_order(it - NKV, 128, 17, mt, nt);
        gemm8_tile<true, false, 0, true>(wid_s, P_HKV, P_WB_IN, 2048, mt * 256, nt * 256,
                  [=](int m, int n, u32x4 v) {
                    if (n >= LDQG) return;
                    *(u32x4*)(P_QG + (long)m * LDQG + n) = v;
                  }, lds);
      }
    }
  }
  grid_barrier(wid_s, (unsigned*)(p.ws + OFF_BAR), 6u * (unsigned)G);

  {
    for (int it = blockIdx.x; ; it += G) {
      int idx; bool is_gemm;
      if (G > 128) {
        const int rnd = it / G;
        if (blockIdx.x < 128) { if (rnd > 0) break; is_gemm = true; idx = blockIdx.x; }
        else { idx = rnd * (G - 128) + (int)blockIdx.x - 128; if (idx >= 512) break; is_gemm = false; }
      } else {
        if (it >= 128 + 512) break;
        is_gemm = it < 128; idx = is_gemm ? it : it - 128;
      }
      if (is_gemm) {
        const int kh = idx >> 6, br = (idx >> 5) & 1, mt = idx & 31;
        float* part = (float*)(p.ws + OFF_PART) + ((long)(kh * 2 + br) * 8192) * 256;
        const int bg0 = mt * 2, b0 = bg0 >> 2, g0 = bg0 & 3;
        gemm8_tile<true, true, 32>(wid_s, P_KV + ((long)b0 * SEQ + 16 * kh) * LDKV + br * 512 + g0 * 128,
                  P_W1T + (long)br * 256 * 4096 + kh * 2048, 4096, mt * 256, 0,
                  [=](int m, int n, float v0, float v1, float v2, float v3) {
                    *(float4*)(part + (long)m * 256 + n) = make_float4(v0, v1, v2, v3);
                  }, lds);
      } else {
        mem_attn_item(wid_s, idx, P_QG, LDQG, 3072, 3584, p.mem_q_norm + 128, P_MEMK + 16384 * 128, P_MEMVT + 16384 * 128, P_Y2, lds);
      }
    }
    rownorm128(wid_s, P_KV + 1024, LDKV, 2, (long)T * 4, p.kn_slc);
    rownorm128(wid_s, P_KV + 2048, LDKV, 2, (long)T * 4, p.kn_win);
  }
  grid_barrier(wid_s, (unsigned*)(p.ws + OFF_BAR), 7u * (unsigned)G);

  {
    for (int it = blockIdx.x; it < 64; it += G) {
      {
        const int br = it >> 5, mt = it & 31;
        u16* hid = P_HID + (long)br * 8192 * 256;
        {
          const float* p0 = (const float*)(p.ws + OFF_PART) + ((long)br * 8192 + mt * 256) * 256;
          const float* p1 = p0 + (long)2 * 8192 * 256;
          const float* bias = P_BIAS + br * 256;
          const int tidl = TIDX();
#pragma unroll 4
          for (int e = tidl; e < 256 * 64; e += NTHR) {
            const float4 a = ((const float4*)p0)[e], b = ((const float4*)p1)[e];
            const float4 bs = *(const float4*)(bias + (e & 63) * 4);
            uint2 w;
            w.x = pk2(silu_f(a.x + b.x + bs.x), silu_f(a.y + b.y + bs.y));
            w.y = pk2(silu_f(a.z + b.z + bs.z), silu_f(a.w + b.w + bs.w));
            *(uint2*)(hid + (long)mt * 256 * 256 + (long)e * 4) = w;
          }
          __syncthreads();
        }
        gemm_tile(wid_s, [=](int m, int k) { return hid + (long)m * 256 + k; }, P_W2T + (long)br * 128 * 256, 256, mt * 256, 0,
                  [=](int m, int n, float v0, float v1, float v2, float v3) {
                    if (n >= 128) return;
                    const unsigned a = pk2(v0, v1), b = pk2(v2, v3);
                    if (br == 0) {
                      u16* c = P_KC + (long)m * 128 + n;
                      c[0] = (u16)a; c[128] = (u16)(a >> 16); c[256] = (u16)b; c[384] = (u16)(b >> 16);
                    } else {
                      uint2 w; w.x = a; w.y = b;
                      *(uint2*)(P_VCT + ((long)(m >> 7) * 128 + n) * 128 + (m & 127)) = w;
                    }
                  }, lds);
      }
    }
    for (int rep = 0; rep < PROBE_A; ++rep)
    for (int it = blockIdx.x; it < 1536; it += G) nsa_attn_item<0>(wid_s, it, p, lds);
  }
  grid_barrier(wid_s, (unsigned*)(p.ws + OFF_BAR), 8u * (unsigned)G);

  for (int it = blockIdx.x; it < 512; it += G) cmp_item(wid_s, it, p, lds);
  grid_barrier(wid_s, (unsigned*)(p.ws + OFF_BAR), 9u * (unsigned)G);

  for (int rep = 0; rep < PROBE_A; ++rep)
  for (int it = blockIdx.x; it < 1536; it += G) nsa_attn_item<1>(wid_s, it, p, lds);
  grid_barrier(wid_s, (unsigned*)(p.ws + OFF_BAR), 10u * (unsigned)G);

  for (int it = blockIdx.x; it < 128 * 8; it += G) {
    int mt, nt;
    tile_order(it, 128, 8, mt, nt);
    float* xo = p.out;
    gemm8_tile<true, false>(wid_s, P_Y2, P_WB_OUT, 2048, mt * 256, nt * 256,
              [=](int m, int n, float v0, float v1, float v2, float v3) {
                const long o = (long)m * 2048 + n;
                float4 r = *(const float4*)(xo + o);
                r.x += v0; r.y += v1; r.z += v2; r.w += v3;
                *(float4*)(xo + o) = r;
              }, lds);
  }
}

extern "C" void kernel_launch(void* const* d_in, const int* in_sizes, int n_in,
                              void* d_out, int out_size, void* d_ws, size_t ws_size,
                              hipStream_t stream) {
  static int grid_blocks = 0;
  if (!grid_blocks) {
    int dev = 0, cus = 0, per_cu = 0;
    (void)hipGetDevice(&dev);
    (void)hipDeviceGetAttribute(&cus, hipDeviceAttributeMultiprocessorCount, dev);
    (void)hipFuncSetAttribute((const void*)mega, hipFuncAttributeMaxDynamicSharedMemorySize, LDS_BYTES);
    (void)hipOccupancyMaxActiveBlocksPerMultiprocessor(&per_cu, mega, NTHR, LDS_BYTES);
    if (per_cu > 1) per_cu = 1;
    if (per_cu < 1) per_cu = 1;
    grid_blocks = cus * per_cu;
  }
  Params p{};
  const float** pf = (const float**)&p;
  for (int i = 0; i < 27; ++i) pf[i] = (const float*)d_in[i];
  p.out = (float*)d_out;
  p.ws = (char*)d_ws;
  void* args[] = {&p};
  hipError_t e = hipLaunchCooperativeKernel((void*)mega, dim3(grid_blocks), dim3(NTHR), args, LDS_BYTES, stream);
  if (e != hipSuccess) fprintf(stderr, "cooperative launch failed: %s (grid %d)\n", hipGetErrorString(e), grid_blocks);
}
```

```cpp
#include <hip/hip_runtime.h>
#include <hip/hip_cooperative_groups.h>
#include <cstdio>
#include <cstdint>
namespace cg = cooperative_groups;

typedef unsigned short u16;
typedef __attribute__((ext_vector_type(8))) short bf16x8;
typedef __attribute__((ext_vector_type(4))) short s16x4;
typedef __attribute__((ext_vector_type(16))) float f32x16;
typedef __attribute__((ext_vector_type(4))) unsigned u32x4;
typedef __attribute__((ext_vector_type(2))) __bf16 bf2_t;
typedef __attribute__((ext_vector_type(2))) float f2_t;
#define DI __device__ __forceinline__
#define TIDX() ({ int t_; asm volatile("v_mbcnt_lo_u32_b32 %0, -1, 0\n\tv_mbcnt_hi_u32_b32 %0, -1, %0\n\tv_lshl_or_b32 %0, %1, 6, %0" : "=&v"(t_) : "s"(wid_s)); t_; })
#define MFMA(a, b, c) __builtin_amdgcn_mfma_f32_32x32x16_bf16((a), (b), (c), 0, 0, 0)

#ifndef PROBE_G
#define PROBE_G 1
#endif
#ifndef PROBE_A
#define PROBE_A 1
#endif
#ifndef PROBE_M
#define PROBE_M 1
#endif
#ifndef PROBE_REP_U
#define PROBE_REP_U 1
#endif
#ifndef PROBE_REP_ATT
#define PROBE_REP_ATT 1
#endif
constexpr int T = 32768, SEQ = 2048;
constexpr int LDU = 7168, LDQG = 4224, LDKV = 3072;
constexpr float EPS = 1e-6f;
constexpr float QMULT = 0.08838834764831845f * 1.4426950408889634f;

constexpr size_t MiB = 1ull << 20;
constexpr size_t OFF_WA_IN = 0, OFF_WA_OUT = 28 * MiB, OFF_WKV = 36 * MiB, OFF_WB_IN = 48 * MiB, OFF_WB_OUT = 65 * MiB;
constexpr size_t OFF_WMEM = 73 * MiB, OFF_W1 = 81 * MiB, OFF_W2 = 85 * MiB;
constexpr size_t OFF_BIASP = 85 * MiB + 256 * 1024, OFF_BIAS = 85 * MiB + 512 * 1024;
constexpr size_t OFF_MEMH = 88 * MiB, OFF_MEMK = 120 * MiB, OFF_MEMVT = 128 * MiB;
constexpr size_t OFF_HID = 136 * MiB, OFF_KC = 144 * MiB, OFF_VCT = 146 * MiB, OFF_SEL = 148 * MiB;
constexpr size_t OFF_BAR = 159 * MiB;
constexpr size_t OFF_H1 = 160 * MiB;
constexpr size_t OFF_VTS = 160 * MiB, OFF_VTW = 192 * MiB;
constexpr size_t OFF_U = 288 * MiB;
constexpr size_t OFF_HKV = 288 * MiB, OFF_HB = 416 * MiB, OFF_KV = 544 * MiB, OFF_Y2 = 288 * MiB, OFF_OSUM = 416 * MiB;
constexpr size_t OFF_QG = 736 * MiB;
constexpr size_t OFF_PART = 512 * MiB;

constexpr int NTHR = 512;
constexpr int STG_WAVE = 32 * 272;
constexpr int LDS_BYTES = 147456;
constexpr int GEMM_BUF = 512 * 144;
constexpr int ATT_BUF = 2 * 128 * 272;

struct Params {
  const float *x, *mem, *a_norm, *a_w_in, *a_conv_w, *a_conv_b, *a_w_out, *kv_norm, *kv_w;
  const float *cmp_pos_k, *cmp_w1_k, *cmp_w2_k, *cmp_pos_v, *cmp_w1_v, *cmp_w2_v, *kn_cmp, *kn_slc, *kn_win;
  const float *b_norm, *b_w_in, *b_gate_bias, *b_q_norm, *b_w_out, *mem_norm, *mem_w_kv, *mem_q_norm, *mem_k_norm;
  float* out;
  char* ws;
};

DI unsigned pk2(float a, float b) {
  f2_t v = {a, b};
  bf2_t r = __builtin_convertvector(v, bf2_t);
  return __builtin_bit_cast(unsigned, r);
}
DI float bflo(unsigned w) { return __uint_as_float(w << 16); }
DI float bfhi(unsigned w) { return __uint_as_float(w & 0xffff0000u); }
DI void unpack8(uint4 v, float (&f)[8]) {
  f[0] = bflo(v.x); f[1] = bfhi(v.x); f[2] = bflo(v.y); f[3] = bfhi(v.y);
  f[4] = bflo(v.z); f[5] = bfhi(v.z); f[6] = bflo(v.w); f[7] = bfhi(v.w);
}
DI uint4 pack8(const float (&f)[8]) {
  uint4 r; r.x = pk2(f[0], f[1]); r.y = pk2(f[2], f[3]); r.z = pk2(f[4], f[5]); r.w = pk2(f[6], f[7]); return r;
}
DI int crow(int r, int h) { return (r & 3) + 8 * (r >> 2) + 4 * h; }
DI float silu_f(float z) { return z / (1.f + __expf(-z)); }
DI float sigmoid_f(float z) { return 1.f / (1.f + __expf(-z)); }
DI float xor32_max(float v) {
  auto rr = __builtin_amdgcn_permlane32_swap(__float_as_uint(v), __float_as_uint(v), false, false);
  return fmaxf(__uint_as_float(rr[0]), __uint_as_float(rr[1]));
}
DI float xor32_sum(float v) {
  auto rr = __builtin_amdgcn_permlane32_swap(__float_as_uint(v), __float_as_uint(v), false, false);
  return __uint_as_float(rr[0]) + __uint_as_float(rr[1]);
}
DI float xor32_get(float v, int h) {
  auto rr = __builtin_amdgcn_permlane32_swap(__float_as_uint(v), __float_as_uint(v), false, false);
  return __uint_as_float(h ? rr[0] : rr[1]);
}
DI float wave_sum(float v) {
#pragma unroll
  for (int o = 32; o >= 1; o >>= 1) v += __shfl_xor(v, o);
  return v;
}

DI int mapb(int n) {
  if (n < 1536) return n;
  if (n < 4096) return n + 36;
  if (n < 4132) return n - 2560;
  return -1;
}
DI void transpose_tile(int wid_s, const float* __restrict__ src, int Nsrc, u16* __restrict__ dst, int K, int kt, int nt, int mode,
                       const float* __restrict__ kgain, char* lds) {
  float* tile = (float*)lds;
  const int tid = TIDX();
  const int tx = tid & 63, ty = tid >> 6;
  const int np = nt * 64 + tx;
  const int ns = mode ? mapb(np) : np;
  float v[32];
#pragma unroll
  for (int i = 0; i < 32; ++i) {
    const int k = kt * 256 + ty + 8 * i;
    v[i] = ns >= 0 ? src[(long)k * Nsrc + ns] : 0.f;
  }
#pragma unroll
  for (int i = 0; i < 32; ++i) tile[(ty + 8 * i) * 65 + tx] = v[i];
  __syncthreads();
#pragma unroll
  for (int j = 0; j < 4; ++j) {
    const int c = tid + 512 * j;
    const int kk = c & 7, nl = (c >> 3) & 63, kq = c >> 9;
    float f[8];
#pragma unroll
    for (int e = 0; e < 8; ++e) f[e] = tile[(kq * 64 + kk * 8 + e) * 65 + nl];
    if (kgain) {
      const int k0 = kt * 256 + kq * 64 + kk * 8;
      const float4 ga = *(const float4*)(kgain + k0), gb = *(const float4*)(kgain + k0 + 4);
      f[0] *= ga.x; f[1] *= ga.y; f[2] *= ga.z; f[3] *= ga.w; f[4] *= gb.x; f[5] *= gb.y; f[6] *= gb.z; f[7] *= gb.w;
    }
    *(uint4*)(dst + (long)(nt * 64 + nl) * K + kt * 256 + kq * 64 + kk * 8) = pack8(f);
  }
  __syncthreads();
}

DI void rmsnorm_rows(int wid_s, const float* __restrict__ src, int nrows, const float* __restrict__ g1, u16* __restrict__ d1,
                     const float* __restrict__ g2, u16* __restrict__ d2) {
  const int tidl = TIDX();
  const int lane = tidl & 63;
  const int gw = blockIdx.x * 8 + (tidl >> 6), nw = gridDim.x * 8;
  for (int row = gw * 2; row < nrows; row += nw * 2) {
    const float4* s4 = (const float4*)(src + (long)row * 2048);
    float4 v[16];
#pragma unroll
    for (int i = 0; i < 16; ++i) v[i] = s4[i * 64 + lane];
    float ss0 = 0.f, ss1 = 0.f;
#pragma unroll
    for (int i = 0; i < 8; ++i) {
      ss0 += v[i].x * v[i].x + v[i].y * v[i].y + v[i].z * v[i].z + v[i].w * v[i].w;
      ss1 += v[8 + i].x * v[8 + i].x + v[8 + i].y * v[8 + i].y + v[8 + i].z * v[8 + i].z + v[8 + i].w * v[8 + i].w;
    }
    ss0 = wave_sum(ss0);
    ss1 = wave_sum(ss1);
    const float rs0 = rsqrtf(ss0 * (1.f / 2048.f) + EPS), rs1 = rsqrtf(ss1 * (1.f / 2048.f) + EPS);
    const bool odd = lane & 1;
#pragma unroll
    for (int i = 0; i < 16; i += 2) {
      const int cA = ((i & 7) * 64 + lane) * 4, cB = cA + 256;
      const float rs = i < 8 ? rs0 : rs1;
      const long orow = (long)(row + (i >> 3)) * 2048;
      const long o = orow + (odd ? cB - 4 : cA);
      {
        const float4 one4 = make_float4(1.f, 1.f, 1.f, 1.f);
        const float4 gA = g1 ? *(const float4*)(g1 + cA) : one4, gB = g1 ? *(const float4*)(g1 + cB) : one4;
        const unsigned ax = pk2(v[i].x * rs * gA.x, v[i].y * rs * gA.y), ay = pk2(v[i].z * rs * gA.z, v[i].w * rs * gA.w);
        const unsigned bx = pk2(v[i + 1].x * rs * gB.x, v[i + 1].y * rs * gB.y), by = pk2(v[i + 1].z * rs * gB.z, v[i + 1].w * rs * gB.w);
        const unsigned rx = (unsigned)__shfl_xor((int)(odd ? ax : bx), 1), ry = (unsigned)__shfl_xor((int)(odd ? ay : by), 1);
        u32x4 w;
        if (odd) { w[0] = rx; w[1] = ry; w[2] = bx; w[3] = by; } else { w[0] = ax; w[1] = ay; w[2] = rx; w[3] = ry; }
        *(u32x4*)(d1 + o) = w;
      }
      if (d2) {
        const float4 gA = *(const float4*)(g2 + cA), gB = *(const float4*)(g2 + cB);
        const unsigned ax = pk2(v[i].x * rs * gA.x, v[i].y * rs * gA.y), ay = pk2(v[i].z * rs * gA.z, v[i].w * rs * gA.w);
        const unsigned bx = pk2(v[i + 1].x * rs * gB.x, v[i + 1].y * rs * gB.y), by = pk2(v[i + 1].z * rs * gB.z, v[i + 1].w * rs * gB.w);
        const unsigned rx = (unsigned)__shfl_xor((int)(odd ? ax : bx), 1), ry = (unsigned)__shfl_xor((int)(odd ? ay : by), 1);
        u32x4 w;
        if (odd) { w[0] = rx; w[1] = ry; w[2] = bx; w[3] = by; } else { w[0] = ax; w[1] = ay; w[2] = rx; w[3] = ry; }
        *(u32x4*)(d2 + o) = w;
      }
    }
  }
}

DI void rownorm128(int wid_s, u16* base, long outer_stride, int rpg_shift, long nrows, const float* __restrict__ gain) {
  const int tidl = TIDX();
  const int l16 = tidl & 15;
  const long gq = ((long)blockIdx.x * NTHR + tidl) >> 4, nq = ((long)gridDim.x * NTHR) >> 4;
  for (long r = gq; r < nrows; r += nq) {
    u16* ptr = base + (r >> rpg_shift) * outer_stride + (r & ((1 << rpg_shift) - 1)) * 128 + l16 * 8;
    uint4 v = *(const uint4*)ptr;
    float f[8];
    unpack8(v, f);
    float ss = 0.f;
#pragma unroll
    for (int j = 0; j < 8; ++j) ss += f[j] * f[j];
    ss += __shfl_xor(ss, 1); ss += __shfl_xor(ss, 2); ss += __shfl_xor(ss, 4); ss += __shfl_xor(ss, 8);
    const float rs = rsqrtf(ss * (1.f / 128.f) + EPS);
    float4 ga = *(const float4*)(gain + l16 * 8), gb = *(const float4*)(gain + l16 * 8 + 4);
    f[0] *= rs * ga.x; f[1] *= rs * ga.y; f[2] *= rs * ga.z; f[3] *= rs * ga.w;
    f[4] *= rs * gb.x; f[5] *= rs * gb.y; f[6] *= rs * gb.z; f[7] *= rs * gb.w;
    *(uint4*)ptr = pack8(f);
  }
}

DI void conv_pass(int wid_s, const u16* __restrict__ U, const float* __restrict__ cw, const float* __restrict__ cbias, u16* __restrict__ Y) {
  const long total = (long)(T / 4) * 192;
  const long gs = (long)gridDim.x * NTHR;
  const int tidl = TIDX();
  for (long idx = (long)blockIdx.x * NTHR + tidl; idx < total; idx += gs) {
    const int tg = (int)(idx / 192);
    const int c = (int)(idx - (long)tg * 192) * 8;
    const int t0 = tg * 4;
    const bool first = (t0 & (SEQ - 1)) == 0;
    const u16* row = U + (long)t0 * LDU;
    const long hoff = first ? 0 : -2 * (long)LDU;
    uint4 rc[6], rh[6], rb[4], rz[4];
    rc[0] = *(const uint4*)(row + hoff + 1536 + c);           rh[0] = *(const uint4*)(row + hoff + 3072 + c);
    rc[1] = *(const uint4*)(row + hoff / 2 + 1536 + c);       rh[1] = *(const uint4*)(row + hoff / 2 + 3072 + c);
#pragma unroll
    for (int i = 0; i < 4; ++i) {
      rc[2 + i] = *(const uint4*)(row + (long)i * LDU + 1536 + c);
      rh[2 + i] = *(const uint4*)(row + (long)i * LDU + 3072 + c);
      rb[i] = *(const uint4*)(row + (long)i * LDU + c);
      rz[i] = *(const uint4*)(row + (long)i * LDU + 4608 + c);
    }
    float w0[8], w1[8], w2[8], bb[8];
    *(float4*)&w0[0] = *(const float4*)(cw + c); *(float4*)&w0[4] = *(const float4*)(cw + c + 4);
    *(float4*)&w1[0] = *(const float4*)(cw + 1536 + c); *(float4*)&w1[4] = *(const float4*)(cw + 1536 + c + 4);
    *(float4*)&w2[0] = *(const float4*)(cw + 3072 + c); *(float4*)&w2[4] = *(const float4*)(cw + 3072 + c + 4);
    *(float4*)&bb[0] = *(const float4*)(cbias + c); *(float4*)&bb[4] = *(const float4*)(cbias + c + 4);
    float u[6][8];
#pragma unroll
    for (int i = 0; i < 6; ++i) {
      float a[8], b[8];
      unpack8(rc[i], a); unpack8(rh[i], b);
#pragma unroll
      for (int j = 0; j < 8; ++j) u[i][j] = (i < 2 && first) ? 0.f : a[j] * b[j];
    }
#pragma unroll
    for (int i = 0; i < 4; ++i) {
      float fb[8], fz[8], acc[8];
      unpack8(rb[i], fb); unpack8(rz[i], fz);
#pragma unroll
      for (int j = 0; j < 8; ++j) {
        acc[j] = bb[j] + w0[j] * u[i][j] + w1[j] * u[i + 1][j] + w2[j] * u[i + 2][j];
        acc[j] = fb[j] * acc[j] * silu_f(fz[j]);
      }
      *(uint4*)(Y + (long)(t0 + i) * 2048 + c) = pack8(acc);
    }
  }
}

template <class AF, class EF>
DI void gemm_tile(int wid_s, AF af, const u16* __restrict__ Bt, int K, int m0, int n0, EF ef, char* lds) {
  const int tid = TIDX(), lane = tid & 63, wid = wid_s, r32 = lane & 31, h = lane >> 5;
  const int wm = wid >> 1, wn = wid & 1;
  const int lrow = tid >> 3, lch = tid & 7;
  f32x16 acc[2][4];
#pragma unroll
  for (int i = 0; i < 2; ++i)
#pragma unroll
    for (int j = 0; j < 4; ++j)
#pragma unroll
      for (int r = 0; r < 16; ++r) acc[i][j][r] = 0.f;
  u32x4 ra0[4], rb0[4];
  const int nk = K >> 6;
#define G_LOAD(RA, RB, KT)                                                      \
  {                                                                             \
    const int k_ = (KT) * 64 + lch * 8;                                         \
    _Pragma("unroll") for (int i = 0; i < 4; ++i) {                             \
      RA[i] = *(const u32x4*)af(m0 + lrow + 64 * i, k_);                        \
      RB[i] = *(const u32x4*)(Bt + (long)(n0 + lrow + 64 * i) * K + k_);        \
    }                                                                           \
  }
#define G_WRITE(RA, RB, BUF)                                                    \
  {                                                                             \
    char* An_ = lds + (BUF) * GEMM_BUF;                                         \
    _Pragma("unroll") for (int i = 0; i < 4; ++i) {                             \
      *(u32x4*)(An_ + (lrow + 64 * i) * 144 + lch * 16) = RA[i];                \
      *(u32x4*)(An_ + 256 * 144 + (lrow + 64 * i) * 144 + lch * 16) = RB[i];    \
    }                                                                           \
  }
#define G_STEP(RA, RB, BUF)                                                     \
  {                                                                             \
    const char* As = lds + (BUF) * GEMM_BUF + (wm * 64 + r32) * 144 + h * 16;   \
    const char* Bs = lds + (BUF) * GEMM_BUF + (256 + wn * 128 + r32) * 144 + h * 16; \
    char* Wn = lds + ((BUF) ^ 1) * GEMM_BUF + lrow * 144 + lch * 16;            \
    _Pragma("unroll") for (int ks = 0; ks < 4; ++ks) {                          \
      bf16x8 a0 = *(const bf16x8*)(As + ks * 32);                               \
      bf16x8 a1 = *(const bf16x8*)(As + 32 * 144 + ks * 32);                    \
      bf16x8 b0 = *(const bf16x8*)(Bs + ks * 32);                               \
      bf16x8 b1 = *(const bf16x8*)(Bs + 32 * 144 + ks * 32);                    \
      bf16x8 b2 = *(const bf16x8*)(Bs + 64 * 144 + ks * 32);                    \
      bf16x8 b3 = *(const bf16x8*)(Bs + 96 * 144 + ks * 32);                    \
      acc[0][0] = MFMA(a0, b0, acc[0][0]);                                      \
      acc[0][1] = MFMA(a0, b1, acc[0][1]);                                      \
      if (ks == 2) *(u32x4*)(Wn) = RA[0];                                       \
      if (ks == 3) *(u32x4*)(Wn + 256 * 144) = RB[0];                           \
      acc[0][2] = MFMA(a0, b2, acc[0][2]);                                      \
      acc[0][3] = MFMA(a0, b3, acc[0][3]);                                      \
      if (ks == 2) *(u32x4*)(Wn + 64 * 144) = RA[1];                            \
      if (ks == 3) *(u32x4*)(Wn + 320 * 144) = RB[1];                           \
      acc[1][0] = MFMA(a1, b0, acc[1][0]);                                      \
      acc[1][1] = MFMA(a1, b1, acc[1][1]);                                      \
      if (ks == 2) *(u32x4*)(Wn + 128 * 144) = RA[2];                           \
      if (ks == 3) *(u32x4*)(Wn + 384 * 144) = RB[2];                           \
      acc[1][2] = MFMA(a1, b2, acc[1][2]);                                      \
      acc[1][3] = MFMA(a1, b3, acc[1][3]);                                      \
      if (ks == 2) *(u32x4*)(Wn + 192 * 144) = RA[3];                           \
      if (ks == 3) *(u32x4*)(Wn + 448 * 144) = RB[3];                           \
    }                                                                           \
      \
    __builtin_amdgcn_sched_group_barrier(0x100, 6, 0);                          \
    _Pragma("unroll") for (int q = 0; q < 6; ++q) {                             \
      __builtin_amdgcn_sched_group_barrier(0x008, 1, 0);                        \
      __builtin_amdgcn_sched_group_barrier(0x100, 1, 0);                        \
    }                                                                           \
    __builtin_amdgcn_sched_group_barrier(0x008, 2, 0);                          \
    _Pragma("unroll") for (int q = 0; q < 6; ++q) {                             \
      __builtin_amdgcn_sched_group_barrier(0x008, 1, 0);                        \
      __builtin_amdgcn_sched_group_barrier(0x100, 1, 0);                        \
    }                                                                           \
    __builtin_amdgcn_sched_group_barrier(0x008, 2, 0);                          \
    _Pragma("unroll") for (int q = 0; q < 4; ++q) {                             \
      __builtin_amdgcn_sched_group_barrier(0x008, 1, 0);                        \
      __builtin_amdgcn_sched_group_barrier(0x100, 1, 0);                        \
      __builtin_amdgcn_sched_group_barrier(0x008, 1, 0);                        \
      __builtin_amdgcn_sched_group_barrier(0x200, 1, 0);                        \
    }                                                                           \
    __builtin_amdgcn_sched_group_barrier(0x100, 2, 0);                          \
    _Pragma("unroll") for (int q = 0; q < 4; ++q) {                             \
      __builtin_amdgcn_sched_group_barrier(0x008, 2, 0);                        \
      __builtin_amdgcn_sched_group_barrier(0x200, 1, 0);                        \
    }                                                                           \
  }
  G_LOAD(ra0, rb0, 0);
  G_WRITE(ra0, rb0, 0);
  __syncthreads();
  for (int kt = 0; kt < nk; kt += 2) {
    G_LOAD(ra0, rb0, kt + 1);
    __builtin_amdgcn_sched_barrier(0);
    G_STEP(ra0, rb0, 0);
    __builtin_amdgcn_sched_barrier(0);
    __syncthreads();
    { const int kn = (kt + 2 < nk) ? kt + 2 : nk - 1; G_LOAD(ra0, rb0, kn); }
    __builtin_amdgcn_sched_barrier(0);
    G_STEP(ra0, rb0, 1);
    __builtin_amdgcn_sched_barrier(0);
    __syncthreads();
  }
#undef G_STEP
#undef G_LOAD
#undef G_WRITE
#pragma unroll
  for (int i = 0; i < 2; ++i)
#pragma unroll
    for (int j = 0; j < 4; ++j)
#pragma unroll
      for (int g = 0; g < 4; ++g) {
        const int m = m0 + wm * 64 + i * 32 + 8 * g + 4 * h;
        const int n = n0 + wn * 128 + j * 32 + r32;
        ef(m, n, acc[i][j][4 * g], acc[i][j][4 * g + 1], acc[i][j][4 * g + 2], acc[i][j][4 * g + 3]);
      }
}


constexpr int G8_HT = 128 * 64;
DI int g8_lds_byte(int r, int c) {
  int st = (r >> 4) * 2 + (c >> 5), rr = r & 15, cc = c & 31, ob = rr * 64 + cc * 2;
  return st * 1024 + (ob ^ (((ob >> 9) & 1) << 5));
}
DI void g8_stage_rc(int b, int& R, int& C) {
  int st = b / 1024, sb = b % 1024, swz = sb ^ (((sb >> 9) & 1) << 5);
  R = (st >> 1) * 16 + swz / 64; C = (st & 1) * 32 + (swz % 64) / 2;
}
template <bool SWAP, bool CMP, int NKT = 0, bool WIDE = false, class EF>
DI void gemm8_tile(int wid_s, const u16* __restrict__ A, const u16* __restrict__ Bt, int K, int brow, int bcol, EF ef, char* lds) {
  typedef __attribute__((ext_vector_type(4))) float f32x4;
  u16* shm = (u16*)lds;
  const int tid = TIDX();
#define SA(b, h) (shm + ((b) * 2 + (h)) * G8_HT)
#define SB(b, h) (shm + (4 + (b) * 2 + (h)) * G8_HT)
#define STAGE(P, BASE, br, kt) do { long _g = (long)(br) * K + (long)(kt) * 64; \
    for (int _i = 0; _i < 2; ++_i) { int _b = tid * 16 + _i * 8192; int _r, _c; g8_stage_rc(_b, _r, _c); \
      __builtin_amdgcn_global_load_lds((const unsigned*)(BASE + _g + (long)_r * K + _c), \
        (__attribute__((address_space(3))) unsigned*)((char*)(P) + _b), 16, 0, 0); } } while (0)
#define STAGE_A(P, hsel, kt) do { \
    for (int _i = 0; _i < 2; ++_i) { int _b = tid * 16 + _i * 8192; int _r, _c; g8_stage_rc(_b, _r, _c); \
      const u16* _src = CMP ? (A + (hsel) * 128 + (long)(_r > 126 ? 126 : _r) * (16 * LDKV) + (long)((kt) >> 1) * LDKV + ((kt) & 1) * 64 + _c) \
                            : (A + (long)(brow + (hsel) * 128 + _r) * K + (long)(kt) * 64 + _c); \
      __builtin_amdgcn_global_load_lds((const unsigned*)_src, \
        (__attribute__((address_space(3))) unsigned*)((char*)(P) + _b), 16, 0, 0); } } while (0)
#define LDA(dst, b, h) for (int m = 0; m < 4; ++m) for (int k = 0; k < 2; ++k) \
    dst[m][k] = *reinterpret_cast<const bf16x8*>((char*)SA(b, h) + g8_lds_byte(wr * 64 + m * 16 + fr, k * 32 + fq * 8))
#define LDB(dst, b, h) for (int n = 0; n < 2; ++n) for (int k = 0; k < 2; ++k) \
    dst[n][k] = *reinterpret_cast<const bf16x8*>((char*)SB(b, h) + g8_lds_byte(wc * 32 + n * 16 + fr, k * 32 + fq * 8))
#define MMA(ai, bj, At, Bx) do { __builtin_amdgcn_s_setprio(1); \
    for (int m = 0; m < 4; ++m) for (int n = 0; n < 2; ++n) for (int k = 0; k < 2; ++k) \
      acc[ai][bj][m][n] = SWAP ? __builtin_amdgcn_mfma_f32_16x16x32_bf16(Bx[n][k], At[m][k], acc[ai][bj][m][n], 0, 0, 0) \
                               : __builtin_amdgcn_mfma_f32_16x16x32_bf16(At[m][k], Bx[n][k], acc[ai][bj][m][n], 0, 0, 0); \
    __builtin_amdgcn_s_setprio(0); } while (0)
#define WAIT_V(n) asm volatile("s_waitcnt vmcnt(" #n ")" ::: "memory")
#define WAIT_L(n) asm volatile("s_waitcnt lgkmcnt(" #n ")" ::: "memory")
#define BAR __builtin_amdgcn_s_barrier()
#define SCHED __builtin_amdgcn_sched_barrier(0)
  const int HALF = 128;
  const int wid = wid_s, lane = tid & 63, wr = wid >> 2, wc = wid & 3, fr = lane & 15, fq = lane >> 4;
  f32x4 acc[2][2][4][2] = {};
  bf16x8 At[4][2], B0[2][2], B1[2][2];
  const int nt = NKT ? NKT : K / 64;
  STAGE(SB(0, 0), Bt, bcol, 0); STAGE_A(SA(0, 0), 0, 0);
  STAGE(SB(0, 1), Bt, bcol + HALF, 0); STAGE_A(SA(0, 1), 1, 0);
  if (wr == 1) BAR;
  WAIT_V(4); BAR;
  STAGE(SB(1, 0), Bt, bcol, 1); STAGE_A(SA(1, 0), 0, 1); STAGE(SB(1, 1), Bt, bcol + HALF, 1);
  WAIT_V(6); BAR;
  for (int t = 0; t < nt - 2; t += 2) {
    LDB(B0, 0, 0); SCHED; LDA(At, 0, 0); STAGE_A(SA(1, 1), 1, t + 1);
    WAIT_L(8); BAR; WAIT_L(0); MMA(0, 0, At, B0); BAR; SCHED;
    LDB(B1, 0, 1); STAGE(SB(0, 0), Bt, bcol, t + 2);
    BAR; WAIT_L(0); MMA(0, 1, At, B1); BAR;
    LDA(At, 0, 1); STAGE_A(SA(0, 0), 0, t + 2);
    BAR; WAIT_L(0); MMA(1, 0, At, B0); BAR; SCHED;
    STAGE(SB(0, 1), Bt, bcol + HALF, t + 2);
    WAIT_V(6); BAR; MMA(1, 1, At, B1); BAR;
    LDB(B0, 1, 0); SCHED; LDA(At, 1, 0); STAGE_A(SA(0, 1), 1, t + 2);
    WAIT_L(8); BAR; WAIT_L(0); MMA(0, 0, At, B0); BAR; SCHED;
    LDB(B1, 1, 1); STAGE(SB(1, 0), Bt, bcol, t + 3);
    BAR; WAIT_L(0); MMA(0, 1, At, B1); BAR;
    LDA(At, 1, 1); STAGE_A(SA(1, 0), 0, t + 3);
    BAR; WAIT_L(0); MMA(1, 0, At, B0); BAR; SCHED;
    STAGE(SB(1, 1), Bt, bcol + HALF, t + 3);
    WAIT_V(6); BAR; MMA(1, 1, At, B1); BAR;
  }
  { LDB(B0, 0, 0); LDA(At, 0, 0); STAGE_A(SA(1, 1), 1, nt - 1);
    BAR; WAIT_L(0); MMA(0, 0, At, B0); BAR;
    LDB(B1, 0, 1); BAR; WAIT_L(0); MMA(0, 1, At, B1); BAR;
    LDA(At, 0, 1); WAIT_V(4); BAR; WAIT_L(0); MMA(1, 0, At, B0); MMA(1, 1, At, B1); BAR; }
  { LDB(B0, 1, 0); LDA(At, 1, 0); WAIT_V(2); BAR; WAIT_L(0); MMA(0, 0, At, B0); BAR;
    LDB(B1, 1, 1); WAIT_V(0); BAR; WAIT_L(0); MMA(0, 1, At, B1); BAR;
    LDA(At, 1, 1); BAR; WAIT_L(0); MMA(1, 0, At, B0); MMA(1, 1, At, B1); BAR; }
  if (wr == 0) BAR;
  if constexpr (WIDE) {
    const int cb8 = (fq >> 1) * 8 + (fq & 1) * 16;
    if constexpr (!SWAP) {
#pragma unroll
      for (int ai = 0; ai < 2; ++ai)
#pragma unroll
        for (int bj = 0; bj < 2; ++bj)
#pragma unroll
          for (int mp = 0; mp < 4; mp += 2)
#pragma unroll
            for (int n = 0; n < 2; ++n) {
              const unsigned a0 = pk2(acc[ai][bj][mp][n][0], acc[ai][bj][mp][n][1]), a1 = pk2(acc[ai][bj][mp][n][2], acc[ai][bj][mp][n][3]);
              const unsigned b0 = pk2(acc[ai][bj][mp + 1][n][0], acc[ai][bj][mp + 1][n][1]), b1 = pk2(acc[ai][bj][mp + 1][n][2], acc[ai][bj][mp + 1][n][3]);
              auto r0 = __builtin_amdgcn_permlane16_swap(a0, b0, false, false);
              auto r1 = __builtin_amdgcn_permlane16_swap(a1, b1, false, false);
              u32x4 v = {r0[0], r1[0], r0[1], r1[1]};
              ef(brow + ai * HALF + wr * 64 + mp * 16 + cb8, bcol + bj * HALF + wc * 32 + n * 16 + fr, v);
            }
    } else
#pragma unroll
    for (int ai = 0; ai < 2; ++ai)
#pragma unroll
      for (int bj = 0; bj < 2; ++bj)
#pragma unroll
        for (int m = 0; m < 4; ++m) {
          const unsigned a0 = pk2(acc[ai][bj][m][0][0], acc[ai][bj][m][0][1]), a1 = pk2(acc[ai][bj][m][0][2], acc[ai][bj][m][0][3]);
          const unsigned b0 = pk2(acc[ai][bj][m][1][0], acc[ai][bj][m][1][1]), b1 = pk2(acc[ai][bj][m][1][2], acc[ai][bj][m][1][3]);
          auto r0 = __builtin_amdgcn_permlane16_swap(a0, b0, false, false);
          auto r1 = __builtin_amdgcn_permlane16_swap(a1, b1, false, false);
          u32x4 v = {r0[0], r1[0], r0[1], r1[1]};
          ef(brow + ai * HALF + wr * 64 + m * 16 + fr, bcol + bj * HALF + wc * 32 + cb8, v);
        }
  } else
#pragma unroll
  for (int ai = 0; ai < 2; ++ai)
#pragma unroll
    for (int bj = 0; bj < 2; ++bj)
#pragma unroll
      for (int m = 0; m < 4; ++m)
#pragma unroll
        for (int n = 0; n < 2; ++n)
          if (SWAP)
            ef(brow + ai * HALF + wr * 64 + m * 16 + fr, bcol + bj * HALF + wc * 32 + n * 16 + fq * 4,
               acc[ai][bj][m][n][0], acc[ai][bj][m][n][1], acc[ai][bj][m][n][2], acc[ai][bj][m][n][3]);
          else
            ef(brow + ai * HALF + wr * 64 + m * 16 + fq * 4, bcol + bj * HALF + wc * 32 + n * 16 + fr,
               acc[ai][bj][m][n][0], acc[ai][bj][m][n][1], acc[ai][bj][m][n][2], acc[ai][bj][m][n][3]);
#undef SA
#undef SB
#undef STAGE
#undef STAGE_A
#undef LDA
#undef LDB
#undef MMA
#undef WAIT_V
#undef WAIT_L
#undef BAR
#undef SCHED
}

DI void tile_order(int idx, int MT, int NT, int& mt, int& nt) {
  const int per_ng = MT * 8;
  const int ng = idx / per_ng;
  const int rem = idx - ng * per_ng;
  int gn = NT - ng * 8; if (gn > 8) gn = 8;
  const int per_mg = 32 * gn;
  const int mg = rem / per_mg;
  const int r2 = rem - mg * per_mg;
  nt = ng * 8 + (r2 >> 5);
  mt = mg * 32 + (r2 & 31);
}

DI void load_q(const u16* __restrict__ q0, long ldq, const float* __restrict__ gain, float mult, char* st, int lane, bf16x8 (&qr)[8]) {
  const int r32 = lane & 31, h = lane >> 5, er = lane >> 4, ec = lane & 15;
#pragma unroll
  for (int j = 0; j < 8; ++j) {
    const int rr = j * 4 + er;
    *(uint4*)(st + rr * 272 + ec * 16) = *(const uint4*)(q0 + (long)rr * ldq + ec * 8);
  }
  uint4 raw[8];
  float ss = 0.f;
#pragma unroll
  for (int d0 = 0; d0 < 8; ++d0) raw[d0] = *(const uint4*)(st + r32 * 272 + (16 * d0 + 8 * h) * 2);
#pragma unroll
  for (int d0 = 0; d0 < 8; ++d0) {
    float f[8];
    unpack8(raw[d0], f);
#pragma unroll
    for (int j = 0; j < 8; ++j) ss += f[j] * f[j];
  }
  ss = xor32_sum(ss);
  const float rs = rsqrtf(ss * (1.f / 128.f) + EPS) * mult;
#pragma unroll
  for (int d0 = 0; d0 < 8; ++d0) {
    float f[8];
    unpack8(raw[d0], f);
    float4 ga = *(const float4*)(gain + 16 * d0 + 8 * h), gb = *(const float4*)(gain + 16 * d0 + 8 * h + 4);
    u32x4 w;
    w[0] = pk2(f[0] * rs * ga.x, f[1] * rs * ga.y);
    w[1] = pk2(f[2] * rs * ga.z, f[3] * rs * ga.w);
    w[2] = pk2(f[4] * rs * gb.x, f[5] * rs * gb.y);
    w[3] = pk2(f[6] * rs * gb.z, f[7] * rs * gb.w);
    qr[d0] = __builtin_bit_cast(bf16x8, w);
  }
}

template <class VF, class AF, class FF>
DI void attn_loop(int wid_s, const bf16x8 (&qr)[8], const u16* __restrict__ Kb, long ldk, const u16* __restrict__ Vt, long ldv,
                  int kt0, int kt1, VF validf, AF activef, FF fullf, f32x16 (&o)[4], float& m_run, float& l_run, char* lds) {
  const int tid = TIDX(), lane = tid & 63, r32 = lane & 31, h = lane >> 5;
  const int lrow = tid >> 4, lch = tid & 15;
  u32x4 rk[4], rv[4];
#define A_GLOAD(KP)                                                                                   \
  _Pragma("unroll") for (int i = 0; i < 4; ++i) {                                                     \
    rk[i] = *(const u32x4*)(Kb + (long)((KP) * 128 + lrow + 32 * i) * ldk + lch * 8);                 \
    rv[i] = *(const u32x4*)(Vt + (long)(lrow + 32 * i) * ldv + (KP) * 128 + lch * 8);                 \
  }
#define A_SWRITE(BUF)                                                                                 \
  _Pragma("unroll") for (int i = 0; i < 4; ++i) {                                                     \
    *(u32x4*)(lds + (BUF) * ATT_BUF + (lrow + 32 * i) * 272 + lch * 16) = rk[i];                      \
    char* vg = lds + (BUF) * ATT_BUF + 128 * 272 + (lrow + 32 * i) * 272 + (lch >> 1) * 32 + (lch & 1) * 8; \
    *(uint2*)vg = make_uint2(rv[i][0], rv[i][1]);                                                     \
    *(uint2*)(vg + 16) = make_uint2(rv[i][2], rv[i][3]);                                              \
  }
  const int kp0 = kt0 >> 1, kp1 = kt1 >> 1;
  A_GLOAD(kp0);
  A_SWRITE(0);
  __syncthreads();
  for (int kp = kp0; kp < kp1; ++kp) {
    const int cur = (kp - kp0) & 1;
    if (kp + 1 < kp1) { A_GLOAD(kp + 1); }
#pragma unroll
    for (int t = 0; t < 2; ++t) {
      const int kt = kp * 2 + t;
      const char* Ks = lds + cur * ATT_BUF + t * 64 * 272;
      const char* Vs = lds + cur * ATT_BUF + 128 * 272 + t * 128;
      if (activef(kt)) {
        f32x16 p0, p1;
#pragma unroll
        for (int r = 0; r < 16; ++r) { p0[r] = 0.f; p1[r] = 0.f; }
        __builtin_amdgcn_s_setprio(1);
#pragma unroll
        for (int d0 = 0; d0 < 8; ++d0) {
          bf16x8 a0 = *(const bf16x8*)(Ks + r32 * 272 + (16 * d0 + 8 * h) * 2);
          bf16x8 a1 = *(const bf16x8*)(Ks + (32 + r32) * 272 + (16 * d0 + 8 * h) * 2);
          p0 = MFMA(a0, qr[d0], p0);
          p1 = MFMA(a1, qr[d0], p1);
        }
        __builtin_amdgcn_s_setprio(0);
        if (!fullf(kt)) {
#pragma unroll
          for (int r = 0; r < 16; ++r) {
            p0[r] = validf(kt * 64 + crow(r, h), kt) ? p0[r] : -1e30f;
            p1[r] = validf(kt * 64 + 32 + crow(r, h), kt) ? p1[r] : -1e30f;
          }
        }
        float mx = m_run;
#pragma unroll
        for (int r = 0; r < 16; ++r) mx = fmaxf(mx, fmaxf(p0[r], p1[r]));
        const float cand = xor32_max(mx);
        if (__builtin_amdgcn_ballot_w64(cand > m_run + 8.f) != 0ull) {
          const float alpha = __builtin_amdgcn_exp2f(m_run - cand);
          m_run = cand;
          l_run *= alpha;
#pragma unroll
          for (int d0 = 0; d0 < 4; ++d0)
#pragma unroll
            for (int r = 0; r < 16; ++r) o[d0][r] *= alpha;
        }
        const float mn = m_run;
        float sum = 0.f;
#pragma unroll
        for (int r = 0; r < 16; ++r) {
          p0[r] = __builtin_amdgcn_exp2f(p0[r] - mn);
          p1[r] = __builtin_amdgcn_exp2f(p1[r] - mn);
          sum += p0[r] + p1[r];
        }
        sum = xor32_sum(sum);
        l_run += sum;
#pragma unroll
        for (int kb = 0; kb < 2; ++kb) {
#pragma unroll
          for (int s = 0; s < 2; ++s) {
            u32x4 w;
            if (kb == 0) {
              w[0] = pk2(p0[8 * s + 0], p0[8 * s + 1]); w[1] = pk2(p0[8 * s + 2], p0[8 * s + 3]);
              w[2] = pk2(p0[8 * s + 4], p0[8 * s + 5]); w[3] = pk2(p0[8 * s + 6], p0[8 * s + 7]);
            } else {
              w[0] = pk2(p1[8 * s + 0], p1[8 * s + 1]); w[1] = pk2(p1[8 * s + 2], p1[8 * s + 3]);
              w[2] = pk2(p1[8 * s + 4], p1[8 * s + 5]); w[3] = pk2(p1[8 * s + 6], p1[8 * s + 7]);
            }
            const bf16x8 xs = __builtin_bit_cast(bf16x8, w);
#pragma unroll
            for (int d0 = 0; d0 < 4; ++d0) {
              const bf16x8 a = *(const bf16x8*)(Vs + (32 * d0 + r32) * 272 + (2 * kb + s) * 32 + h * 16);
              o[d0] = MFMA(a, xs, o[d0]);
            }
          }
        }
      }
    }
    if (kp + 1 < kp1) { A_SWRITE(cur ^ 1); }
    __syncthreads();
  }
#undef A_GLOAD
#undef A_SWRITE
}


DI void stage_o(const f32x16 (&o)[4], float scale, char* st, int r32, int h) {
#pragma unroll
  for (int d0 = 0; d0 < 4; ++d0)
#pragma unroll
    for (int g = 0; g < 4; ++g) {
      uint2 w;
      w.x = pk2(o[d0][4 * g] * scale, o[d0][4 * g + 1] * scale);
      w.y = pk2(o[d0][4 * g + 2] * scale, o[d0][4 * g + 3] * scale);
      *(uint2*)(st + r32 * 272 + (32 * d0 + 8 * g + 4 * h) * 2) = w;
    }
}

DI void mem_attn_item(int wid_s, int it, const u16* __restrict__ Qsrc, long ldq, int qoff, int zoff, const float* __restrict__ qgain,
                      const u16* __restrict__ memK, const u16* __restrict__ memVt, u16* __restrict__ Y, char* lds) {
  const int tid = TIDX(), lane = tid & 63, wid = wid_s, r32 = lane & 31, h = lane >> 5;
  const int qt = it & 7, hm = (it >> 3) & 3, b = it >> 5;
  const int s = qt * 256 + wid * 32 + r32;
  const long row = (long)b * SEQ + s;
  bf16x8 qr[8];
  load_q(Qsrc + ((long)b * SEQ + qt * 256 + wid * 32) * ldq + qoff + hm * 128, ldq, qgain, QMULT, lds + ATT_BUF + wid * STG_WAVE, lane, qr);
  f32x16 o[4];
#pragma unroll
  for (int d0 = 0; d0 < 4; ++d0)
#pragma unroll
    for (int r = 0; r < 16; ++r) o[d0][r] = 0.f;
  float m_run = -1e20f, l_run = 0.f;
  attn_loop(wid_s, qr, memK + (long)(b * 4 + hm) * 256 * 128, 128, memVt + (long)(b * 4 + hm) * 128 * 256, 256, 0, 4,
            [](int, int) { return true; }, [](int) { return true; }, [](int) { return true; }, o, m_run, l_run, lds);
  const float inv = l_run > 0.f ? 1.f / l_run : 0.f;
  char* st = lds + ATT_BUF + wid * STG_WAVE;
  const int tid2 = TIDX();
  const int lane2 = tid2 & 63;
  stage_o(o, inv, st, lane2 & 31, lane2 >> 5);
  const long row0 = (long)b * SEQ + qt * 256 + wid * 32;
  const int er = lane2 >> 4, ec = lane2 & 15;
#pragma unroll
  for (int j = 0; j < 8; ++j) {
    const int rr = j * 4 + er;
    float f[8], z[8];
    unpack8(*(const uint4*)(st + rr * 272 + ec * 16), f);
    unpack8(*(const uint4*)(Qsrc + (row0 + rr) * ldq + zoff + hm * 128 + ec * 8), z);
#pragma unroll
    for (int e = 0; e < 8; ++e) f[e] *= silu_f(z[e]);
    *(uint4*)(Y + (row0 + rr) * 2048 + 1536 + hm * 128 + ec * 8) = pack8(f);
  }
}

template <int MODE>
DI void nsa_attn_item(int wid_s, int it, const Params& p, char* lds) {
  const int tid = TIDX(), lane = tid & 63, wid = wid_s, r32 = lane & 31, h = lane >> 5;
  const u16* QG = (const u16*)(p.ws + OFF_QG);
  const u16* KV = (const u16*)(p.ws + OFF_KV);
  u16* Osum = (u16*)(p.ws + OFF_OSUM);
  int qt, b, head;
  if (gridDim.x == 256) {
    const int blk = it & 255, rnd = it >> 8;
    const int slot = (rnd & 1) ? 31 - (blk >> 3) : (blk >> 3);
    const int idx = rnd * 32 + slot;
    qt = 7 - idx / 24;
    const int rem = idx % 24, pg = (blk & 7) * 8 + rem / 3;
    b = pg >> 2;
    head = (pg & 3) * 3 + rem % 3;
  } else {
    qt = 7 - (it / 192);
    const int r = it % 192;
    head = r % 12; b = r / 12;
  }
  const int g = head / 3;
  const int s0w = qt * 256 + wid * 32;
  const int tq = s0w + r32;
  const long row = (long)b * SEQ + tq;
  bf16x8 qr[8];
  load_q(QG + ((long)b * SEQ + s0w) * LDQG + head * 128, LDQG, p.b_q_norm, QMULT, lds + ATT_BUF + wid * STG_WAVE, lane, qr);
  f32x16 o[4];
#pragma unroll
  for (int d0 = 0; d0 < 4; ++d0)
#pragma unroll
    for (int rr = 0; rr < 16; ++rr) o[d0][rr] = 0.f;
  float m_run = -1e20f, l_run = 0.f;
  if (MODE == 0) {
    const u16* Kb = KV + (long)b * SEQ * LDKV + 2048 + g * 128;
    const u16* Vt = (const u16*)(p.ws + OFF_VTW) + (long)(b * 4 + g) * 128 * SEQ;
    int kt0 = qt * 4 - 8; if (kt0 < 0) kt0 = 0;
    const int kt1 = qt * 4 + 4;
    attn_loop(wid_s, qr, Kb, LDKV, Vt, SEQ, kt0, kt1,
              [=](int key, int) { const int diff = tq - key; return diff >= 0 && diff < 512; },
              [=](int kt) { return (kt * 64 <= s0w + 31) && (kt * 64 + 63 >= s0w - 511); },
              [=](int kt) { return (kt * 64 + 63 <= s0w) && (kt * 64 >= s0w - 480); }, o, m_run, l_run, lds);
  } else {
    const u16* Kb = KV + (long)b * SEQ * LDKV + 1024 + g * 128;
    const u16* Vt = (const u16*)(p.ws + OFF_VTS) + (long)(b * 4 + g) * 128 * SEQ;
    const unsigned sel = ((const unsigned*)(p.ws + OFF_SEL))[(long)(b * 4 + g) * SEQ + tq];
    const int kt1 = qt * 4 + 4;
    attn_loop(wid_s, qr, Kb, LDKV, Vt, SEQ, 0, kt1,
              [=](int key, int kt) { return (key <= tq) && ((sel >> kt) & 1u); },
              [=](int kt) { return (kt * 64 <= s0w + 31) && (__ballot((sel >> kt) & 1u) != 0ull); },
              [=](int kt) { return (kt * 64 + 63 <= s0w) && (__ballot((sel >> kt) & 1u) == ~0ull); }, o, m_run, l_run, lds);
  }
  const float inv = l_run > 0.f ? 1.f / l_run : 0.f;
  const int gidx = head * 3 + (MODE == 0 ? 2 : 1);
  const int tid2 = TIDX();
  const int lane2 = tid2 & 63, r32b = lane2 & 31, hb = lane2 >> 5;
  const long row0 = (long)b * SEQ + s0w;
  const float gl = bflo((unsigned)QG[(row0 + r32b) * LDQG + 4096 + gidx]);
  const float gate = sigmoid_f(gl + p.b_gate_bias[gidx]) * inv;
  char* st = lds + ATT_BUF + wid * STG_WAVE;
  stage_o(o, gate, st, r32b, hb);
  const int er = lane2 >> 4, ec = lane2 & 15;
  if (MODE == 0) {
#pragma unroll
    for (int j = 0; j < 8; ++j) {
      const int rr = j * 4 + er;
      *(uint4*)(Osum + (row0 + rr) * 1536 + head * 128 + ec * 8) = *(const uint4*)(st + rr * 272 + ec * 16);
    }
  } else {
    u16* Y2 = (u16*)(p.ws + OFF_Y2);
#pragma unroll
    for (int j = 0; j < 8; ++j) {
      const int rr = j * 4 + er;
      float f[8], z[8], os[8], oc[8];
      u16* yp = Y2 + (row0 + rr) * 2048 + head * 128 + ec * 8;
      unpack8(*(const uint4*)(st + rr * 272 + ec * 16), f);
      unpack8(*(const uint4*)(QG + (row0 + rr) * LDQG + 1536 + head * 128 + ec * 8), z);
      unpack8(*(const uint4*)(Osum + (row0 + rr) * 1536 + head * 128 + ec * 8), os);
      unpack8(*(const uint4*)yp, oc);
#pragma unroll
      for (int e = 0; e < 8; ++e) f[e] = (os[e] + oc[e] + f[e]) * silu_f(z[e]);
      *(uint4*)yp = pack8(f);
    }
  }
}

DI void cmp_item(int wid_s, int it, const Params& p, char* lds) {
  const int tid = TIDX(), lane = tid & 63, wid = wid_s, r32 = lane & 31, h = lane >> 5;
  const u16* QG = (const u16*)(p.ws + OFF_QG);
  const u16* Kc = (const u16*)(p.ws + OFF_KC);
  const u16* Vct = (const u16*)(p.ws + OFF_VCT);
  u16* Osum = (u16*)(p.ws + OFF_OSUM);
  const int qt = it & 7, g = (it >> 3) & 3, b = it >> 5;
  const int bg = b * 4 + g;
  char* Ks = lds;
  char* Vs = lds + 128 * 272;
  {
    const int r0 = tid >> 4, ch = tid & 15;
    float4 ga = *(const float4*)(p.kn_cmp + ch * 8), gb = *(const float4*)(p.kn_cmp + ch * 8 + 4);
#pragma unroll
    for (int i = 0; i < 4; ++i) {
      const int rr = r0 + 32 * i;
      uint4 v = *(const uint4*)(Kc + ((long)bg * 128 + rr) * 128 + ch * 8);
      float f[8];
      unpack8(v, f);
      float ss = 0.f;
#pragma unroll
      for (int j = 0; j < 8; ++j) ss += f[j] * f[j];
      ss += __shfl_xor(ss, 1); ss += __shfl_xor(ss, 2); ss += __shfl_xor(ss, 4); ss += __shfl_xor(ss, 8);
      const float rs = rsqrtf(ss * (1.f / 128.f) + EPS);
      f[0] *= rs * ga.x; f[1] *= rs * ga.y; f[2] *= rs * ga.z; f[3] *= rs * ga.w;
      f[4] *= rs * gb.x; f[5] *= rs * gb.y; f[6] *= rs * gb.z; f[7] *= rs * gb.w;
      *(uint4*)(Ks + rr * 272 + ch * 16) = pack8(f);
      u32x4 vv = *(const u32x4*)(Vct + ((long)bg * 128 + rr) * 128 + ch * 8);
      {
        char* vg = Vs + rr * 272 + (ch >> 1) * 32 + (ch & 1) * 8;
        *(uint2*)vg = make_uint2(vv[0], vv[1]);
        *(uint2*)(vg + 16) = make_uint2(vv[2], vv[3]);
      }
    }
  }
  __syncthreads();
  const int tq = qt * 256 + wid * 32 + r32;
  const long row = (long)b * SEQ + tq;
  float gs[16], last[16];
#pragma unroll
  for (int i = 0; i < 16; ++i) { gs[i] = 0.f; last[i] = 0.f; }
#pragma unroll 1
  for (int j = 0; j < 3; ++j) {
    asm volatile("" ::: "memory");
    const int head = g * 3 + j;
    bf16x8 qr[8];
    load_q(QG + ((long)b * SEQ + qt * 256 + wid * 32) * LDQG + head * 128, LDQG, p.b_q_norm, QMULT, lds + 2 * 128 * 272 + wid * STG_WAVE, lane, qr);
    f32x16 pp[4];
#pragma unroll
    for (int kb = 0; kb < 4; ++kb)
#pragma unroll
      for (int r = 0; r < 16; ++r) pp[kb][r] = 0.f;
#pragma unroll
    for (int d0 = 0; d0 < 8; ++d0) {
#pragma unroll
      for (int kb = 0; kb < 4; ++kb) {
        bf16x8 a = *(const bf16x8*)(Ks + (32 * kb + r32) * 272 + (16 * d0 + 8 * h) * 2);
        pp[kb] = MFMA(a, qr[d0], pp[kb]);
      }
    }
    float mx = -1e30f;
#pragma unroll
    for (int kb = 0; kb < 4; ++kb)
#pragma unroll
      for (int r = 0; r < 16; ++r) {
        const int c = 32 * kb + crow(r, h);
        const bool v = (16 * c + 31 <= tq);
        mx = v ? fmaxf(mx, pp[kb][r]) : mx;
      }
    mx = xor32_max(mx);
    float sum = 0.f;
#pragma unroll
    for (int kb = 0; kb < 4; ++kb)
#pragma unroll
      for (int r = 0; r < 16; ++r) {
        const int c = 32 * kb + crow(r, h);
        const bool v = (16 * c + 31 <= tq);
        pp[kb][r] = v ? __builtin_amdgcn_exp2f(pp[kb][r] - mx) : 0.f;
        sum += pp[kb][r];
      }
    sum = xor32_sum(sum);
    const float inv = sum > 0.f ? 1.f / sum : 0.f;
#pragma unroll
    for (int kb = 0; kb < 4; ++kb)
#pragma unroll
      for (int r = 0; r < 16; ++r) pp[kb][r] *= inv;
#pragma unroll
    for (int kb = 0; kb < 4; ++kb)
#pragma unroll
      for (int g4 = 0; g4 < 4; ++g4) {
        gs[kb * 4 + g4] += pp[kb][4 * g4] + pp[kb][4 * g4 + 1] + pp[kb][4 * g4 + 2] + pp[kb][4 * g4 + 3];
        last[kb * 4 + g4] += pp[kb][4 * g4 + 3];
      }
    bf16x8 xs[8];
#pragma unroll
    for (int kb = 0; kb < 4; ++kb)
#pragma unroll
      for (int s = 0; s < 2; ++s) {
        u32x4 w;
        w[0] = pk2(pp[kb][8 * s + 0], pp[kb][8 * s + 1]); w[1] = pk2(pp[kb][8 * s + 2], pp[kb][8 * s + 3]);
        w[2] = pk2(pp[kb][8 * s + 4], pp[kb][8 * s + 5]); w[3] = pk2(pp[kb][8 * s + 6], pp[kb][8 * s + 7]);
        xs[kb * 2 + s] = __builtin_bit_cast(bf16x8, w);
      }
    f32x16 o[4];
#pragma unroll
    for (int d0 = 0; d0 < 4; ++d0)
#pragma unroll
      for (int r = 0; r < 16; ++r) o[d0][r] = 0.f;
#pragma unroll
    for (int ks = 0; ks < 8; ++ks) {
#pragma unroll
      for (int d0 = 0; d0 < 4; ++d0) {
        const bf16x8 a = *(const bf16x8*)(Vs + (32 * d0 + r32) * 272 + ks * 32 + h * 16);
        o[d0] = MFMA(a, xs[ks], o[d0]);
      }
    }
    const int gidx = head * 3;
    const float gl = bflo((unsigned)QG[row * LDQG + 4096 + gidx]);
    const float gate = sigmoid_f(gl + p.b_gate_bias[gidx]);
    {
      char* st = lds + 2 * 128 * 272 + wid * STG_WAVE;
      stage_o(o, gate, st, r32, h);
      const long row0 = (long)b * SEQ + qt * 256 + wid * 32;
      const int er = lane >> 4, ec = lane & 15;
      u16* Oc = (u16*)(p.ws + OFF_Y2);
#pragma unroll
      for (int jj = 0; jj < 8; ++jj) {
        const int rr = jj * 4 + er;
        *(uint4*)(Oc + (row0 + rr) * 2048 + head * 128 + ec * 8) = *(const uint4*)(st + rr * 272 + ec * 16);
      }
    }
  }
  float sc_own[16];
#pragma unroll
  for (int i = 0; i < 16; ++i) {
    const float pl = xor32_get(last[i], h);
    float prev;
    if (i > 0) {
      const float plm = xor32_get(last[i - 1], h);
      prev = h ? pl : plm;
    } else {
      prev = h ? pl : 0.f;
    }
    sc_own[i] = gs[i] + prev;
  }
  __syncthreads();
  float* sbuf = (float*)lds;
#pragma unroll
  for (int i = 0; i < 16; ++i) sbuf[(wid * 32 + r32) * 33 + 2 * i + h] = sc_own[i];
  __syncthreads();
  float msc[32];
  const int cur = tq >> 6;
#pragma unroll
  for (int jj = 0; jj < 32; ++jj) {
    float v = sbuf[(wid * 32 + r32) * 33 + jj];
    if (jj == 0 || jj == cur || jj == cur - 1) v = 1e4f;
    else if (jj > cur) v = -1e30f;
    msc[jj] = v;
  }
  unsigned mask = 0;
#pragma unroll
  for (int jj = 0; jj < 32; ++jj) {
    int rank = 0;
#pragma unroll
    for (int j2 = 0; j2 < 32; ++j2) {
      if (j2 < jj) rank += (msc[j2] >= msc[jj]) ? 1 : 0;
      else if (j2 > jj) rank += (msc[j2] > msc[jj]) ? 1 : 0;
    }
    if (rank < 16 && jj <= cur) mask |= 1u << jj;
  }
  if (h == 0) ((unsigned*)(p.ws + OFF_SEL))[(long)bg * SEQ + tq] = mask;
  __syncthreads();
}

DI void grid_barrier(int wid_s, unsigned* ctr, unsigned target) {
  __syncthreads();
  if (wid_s == 0) {
    const int lane = (int)__builtin_amdgcn_mbcnt_hi(~0u, __builtin_amdgcn_mbcnt_lo(~0u, 0u));
    if (lane == 0) {
      __atomic_thread_fence(__ATOMIC_RELEASE);
      asm volatile("s_waitcnt vmcnt(0) lgkmcnt(0)" ::: "memory");
      __hip_atomic_fetch_add(ctr, 1u, __ATOMIC_RELAXED, __HIP_MEMORY_SCOPE_AGENT);
      while (__hip_atomic_load(ctr, __ATOMIC_RELAXED, __HIP_MEMORY_SCOPE_AGENT) < target) __builtin_amdgcn_s_sleep(2);
      __atomic_thread_fence(__ATOMIC_ACQUIRE);
      asm volatile("s_waitcnt vmcnt(0) lgkmcnt(0)" ::: "memory");
    }
  }
  __syncthreads();
}

#define P_WA_IN ((u16*)(p.ws + OFF_WA_IN))
#define P_WA_OUT ((u16*)(p.ws + OFF_WA_OUT))
#define P_WKV ((u16*)(p.ws + OFF_WKV))
#define P_WB_IN ((u16*)(p.ws + OFF_WB_IN))
#define P_WB_OUT ((u16*)(p.ws + OFF_WB_OUT))
#define P_WMEM ((u16*)(p.ws + OFF_WMEM))
#define P_W1T ((u16*)(p.ws + OFF_W1))
#define P_W2T ((u16*)(p.ws + OFF_W2))
#define P_MEMH ((u16*)(p.ws + OFF_MEMH))
#define P_MEMK ((u16*)(p.ws + OFF_MEMK))
#define P_MEMVT ((u16*)(p.ws + OFF_MEMVT))
#define P_HID ((u16*)(p.ws + OFF_HID))
#define P_KC ((u16*)(p.ws + OFF_KC))
#define P_VCT ((u16*)(p.ws + OFF_VCT))
#define P_H1 ((u16*)(p.ws + OFF_H1))
#define P_Y1 ((u16*)(p.ws + OFF_H1))
#define P_VTS ((u16*)(p.ws + OFF_VTS))
#define P_VTW ((u16*)(p.ws + OFF_VTW))
#define P_U ((u16*)(p.ws + OFF_U))
#define P_HKV ((u16*)(p.ws + OFF_HKV))
#define P_HB ((u16*)(p.ws + OFF_HB))
#define P_KV ((u16*)(p.ws + OFF_KV))
#define P_Y2 ((u16*)(p.ws + OFF_Y2))
#define P_QG ((u16*)(p.ws + OFF_QG))
#define P_BIASP ((float*)(p.ws + OFF_BIASP))
#define P_BIAS ((float*)(p.ws + OFF_BIAS))
__global__ void __launch_bounds__(512) mega(Params p) {
  extern __shared__ __attribute__((aligned(16))) char lds[];
  cg::grid_group grid = cg::this_grid();
  const int G = gridDim.x;
  const int wid_s = __builtin_amdgcn_readfirstlane((int)threadIdx.x >> 6);
  if (blockIdx.x == 0 && wid_s == 0) {
    if (TIDX() == 0) __hip_atomic_store((unsigned*)(p.ws + OFF_BAR), 0u, __ATOMIC_RELAXED, __HIP_MEMORY_SCOPE_AGENT);
  }
  for (int rep = 0; rep < PROBE_M; ++rep) {
    const int TOTAL = 2708;
    for (int t = blockIdx.x; t < TOTAL; t += G) {
      int r = t;
      const float* src; u16* dst; int K, Nsrc, mode = 0; const float* kgain = nullptr;
      if (r < 896) { src = p.a_w_in; dst = P_WA_IN; K = 2048; Nsrc = 7168; }
      else if ((r -= 896) < 256) { src = p.a_w_out; dst = P_WA_OUT; K = 2048; Nsrc = 2048; }
      else if ((r -= 256) < 384) { src = p.kv_w; dst = P_WKV; K = 2048; Nsrc = 3072; kgain = p.kv_norm; }
      else if ((r -= 384) < 528) { src = p.b_w_in; dst = P_WB_IN; K = 2048; Nsrc = 4132; mode = 1; kgain = p.b_norm; }
      else if ((r -= 528) < 256) { src = p.b_w_out; dst = P_WB_OUT; K = 2048; Nsrc = 2048; }
      else if ((r -= 256) < 128) { src = p.mem_w_kv; dst = P_WMEM; K = 2048; Nsrc = 1024; }
      else if ((r -= 128) < 128) { src = p.mem_w_kv + 2048 * 1024; dst = P_WMEM + 1024 * 2048; K = 2048; Nsrc = 1024; }
      else if ((r -= 128) < 64) { src = p.cmp_w1_k; dst = P_W1T; K = 4096; Nsrc = 256; }
      else if ((r -= 64) < 64) { src = p.cmp_w1_v; dst = P_W1T + 256 * 4096; K = 4096; Nsrc = 256; }
      else if ((r -= 64) < 2) { src = p.cmp_w2_k; dst = P_W2T; K = 256; Nsrc = 128; }
      else { r -= 2; src = p.cmp_w2_v; dst = P_W2T + 128 * 256; K = 256; Nsrc = 128; }
      const int nkt = K >> 8;
      transpose_tile(wid_s, src, Nsrc, dst, K, r % nkt, r / nkt, mode, kgain, lds);
    }
    rmsnorm_rows(wid_s, p.x, T, p.a_norm, P_H1, nullptr, nullptr);
    rmsnorm_rows(wid_s, p.mem, 4096, p.mem_norm, P_MEMH, p.mem_norm + 2048, P_MEMH + 4096 * 2048);
    for (int it = blockIdx.x; it < 32; it += G) {
      const int tid = TIDX();
      const int mat = it >> 4, chunk = (it & 15) * 2 + (tid >> 8), f = tid & 255;
      const float* pos = mat ? p.cmp_pos_v : p.cmp_pos_k;
      const float* w1 = mat ? p.cmp_w1_v : p.cmp_w1_k;
      float acc = 0.f;
      for (int k = chunk * 128; k < chunk * 128 + 128; ++k) acc += pos[k] * w1[(long)k * 256 + f];
      P_BIASP[(mat * 32 + chunk) * 256 + f] = acc;
    }
  }
  grid.sync();

  {
    const int NU = 128 * 28;
    for (int rep = 0; rep < PROBE_G; ++rep)
    for (int it = blockIdx.x; it < NU + 128; it += G) {
      if (it < NU) {
        int mt, nt;
        tile_order(it, 128, 28, mt, nt);
        gemm8_tile<true, false, 0, true>(wid_s, P_H1, P_WA_IN, 2048, mt * 256, nt * 256,
                  [=](int m, int n, u32x4 v) { *(u32x4*)(P_U + (long)m * LDU + n) = v; }, lds);
      } else {
        const int it2 = it - NU;
        const int l = it2 >> 6, rr = it2 & 63, mt = rr & 15, nt = rr >> 4;
        const u16* A = P_MEMH + (long)l * 4096 * 2048;
        u16* mk = P_MEMK + (long)l * 16 * 4 * 256 * 128;
        u16* mv = P_MEMVT + (long)l * 16 * 4 * 256 * 128;
        gemm8_tile<false, false>(wid_s, A, P_WMEM + (long)l * 1024 * 2048, 2048, mt * 256, nt * 256,
                  [=](int m, int n, float v0, float v1, float v2, float v3) {
                    const int b = m >> 8, mtok = m & 255;
                    const unsigned a = pk2(v0, v1), bb = pk2(v2, v3);
                    if (n < 512) {
                      const int hm = n >> 7, d = n & 127;
                      u16* c = mk + ((long)(b * 4 + hm) * 256 + mtok) * 128 + d;
                      c[0] = (u16)a; c[128] = (u16)(a >> 16); c[256] = (u16)bb; c[384] = (u16)(bb >> 16);
                    } else {
                      const int hm = (n - 512) >> 7, d = n & 127;
                      uint2 w; w.x = a; w.y = bb;
                      *(uint2*)(mv + ((long)(b * 4 + hm) * 128 + d) * 256 + mtok) = w;
                    }
                  }, lds);
      }
    }
  }
  grid_barrier(wid_s, (unsigned*)(p.ws + OFF_BAR), 1u * (unsigned)G);

  {
    rownorm128(wid_s, P_MEMK, 128, 0, 16384, p.mem_k_norm);
    rownorm128(wid_s, P_MEMK + 16384 * 128, 128, 0, 16384, p.mem_k_norm + 128);
    for (int rep = 0; rep < PROBE_M; ++rep) conv_pass(wid_s, P_U, p.a_conv_w, p.a_conv_b, P_Y1);
    if (blockIdx.x == 0) {
      const int tid = TIDX();
      {
        const int f = tid;
        float a = 0.f;
        for (int c = 0; c < 32; ++c) a += P_BIASP[((f >> 8) * 32 + c) * 256 + (f & 255)];
        P_BIAS[f] = a;
      }
    }
  }
  grid_barrier(wid_s, (unsigned*)(p.ws + OFF_BAR), 2u * (unsigned)G);

  for (int rep = 0; rep < PROBE_A; ++rep)
  for (int it = blockIdx.x; it < 512; it += G)
    mem_attn_item(wid_s, it, P_U, LDU, 6144, 6656, p.mem_q_norm, P_MEMK, P_MEMVT, P_Y1, lds);
  grid_barrier(wid_s, (unsigned*)(p.ws + OFF_BAR), 3u * (unsigned)G);

  for (int rep = 0; rep < PROBE_G; ++rep)
  for (int it = blockIdx.x; it < 128 * 8; it += G) {
    int mt, nt;
    tile_order(it, 128, 8, mt, nt);
    const float* xin = p.x; float* xo = p.out;
    gemm8_tile<true, false>(wid_s, P_Y1, P_WA_OUT, 2048, mt * 256, nt * 256,
              [=](int m, int n, float v0, float v1, float v2, float v3) {
                const long o = (long)m * 2048 + n;
                float4 r = *(const float4*)(xin + o);
                r.x += v0; r.y += v1; r.z += v2; r.w += v3;
                *(float4*)(xo + o) = r;
              }, lds);
  }
  grid_barrier(wid_s, (unsigned*)(p.ws + OFF_BAR), 4u * (unsigned)G);

  for (int rep = 0; rep < PROBE_M; ++rep) rmsnorm_rows(wid_s, p.out, T, nullptr, P_HKV, nullptr, nullptr);
  grid_barrier(wid_s, (unsigned*)(p.ws + OFF_BAR), 5u * (unsigned)G);

  {
    const int NKV = 128 * 12, NQG = 128 * 17;
    for (int rep = 0; rep < PROBE_G; ++rep)
    for (int it = blockIdx.x; it < NKV + NQG; it += G) {
      if (it < NKV) {
        int mt, nt;
        tile_order(it, 128, 12, mt, nt);
        const int sec = nt >> 1;
        if (sec == 3 || sec == 5) {
          u16* vt = (sec == 3) ? P_VTS : P_VTW;
          gemm8_tile<false, false, 0, true>(wid_s, P_HKV, P_WKV, 2048, mt * 256, nt * 256,
                    [=](int m, int n, u32x4 v) {
                      const int gk = (n & 511) >> 7, d = n & 127, bb = m >> 11, s = m & 2047;
                      *(u32x4*)(vt + ((long)(bb * 4 + gk) * 128 + d) * SEQ + s) = v;
                    }, lds);
        } else {
          gemm8_tile<true, false, 0, true>(wid_s, P_HKV, P_WKV, 2048, mt * 256, nt * 256,
                    [=](int m, int n, u32x4 v) { *(u32x4*)(P_KV + (long)m * LDKV + n) = v; }, lds);
        }
      } else {
        int mt, nt;
        tile_order(it - NKV, 128, 17, mt, nt);
        gemm8_tile<true, false, 0, true>(wid_s, P_HKV, P_WB_IN, 2048, mt * 256, nt * 256,
                  [=](int m, int n, u32x4 v) {
                    if (n >= LDQG) return;
                    *(u32x4*)(P_QG + (long)m * LDQG + n) = v;
                  }, lds);
      }
    }
  }
  grid_barrier(wid_s, (unsigned*)(p.ws + OFF_BAR), 6u * (unsigned)G);

  {
    for (int it = blockIdx.x; ; it += G) {
      int idx; bool is_gemm;
      if (G > 128) {
        const int rnd = it / G;
        if (blockIdx.x < 128) { if (rnd > 0) break; is_gemm = true; idx = blockIdx.x; }
        else { idx = rnd * (G - 128) + (int)blockIdx.x - 128; if (idx >= 512) break; is_gemm = false; }
      } else {
        if (it >= 128 + 512) break;
        is_gemm = it < 128; idx = is_gemm ? it : it - 128;
      }
      if (is_gemm) {
        const int kh = idx >> 6, br = (idx >> 5) & 1, mt = idx & 31;
        float* part = (float*)(p.ws + OFF_PART) + ((long)(kh * 2 + br) * 8192) * 256;
        const int bg0 = mt * 2, b0 = bg0 >> 2, g0 = bg0 & 3;
        gemm8_tile<true, true, 32>(wid_s, P_KV + ((long)b0 * SEQ + 16 * kh) * LDKV + br * 512 + g0 * 128,
                  P_W1T + (long)br * 256 * 4096 + kh * 2048, 4096, mt * 256, 0,
                  [=](int m, int n, float v0, float v1, float v2, float v3) {
                    *(float4*)(part + (long)m * 256 + n) = make_float4(v0, v1, v2, v3);
                  }, lds);
      } else {
        mem_attn_item(wid_s, idx, P_QG, LDQG, 3072, 3584, p.mem_q_norm + 128, P_MEMK + 16384 * 128, P_MEMVT + 16384 * 128, P_Y2, lds);
      }
    }
    rownorm128(wid_s, P_KV + 1024, LDKV, 2, (long)T * 4, p.kn_slc);
    rownorm128(wid_s, P_KV + 2048, LDKV, 2, (long)T * 4, p.kn_win);
  }
  grid_barrier(wid_s, (unsigned*)(p.ws + OFF_BAR), 7u * (unsigned)G);

  {
    for (int it = blockIdx.x; it < 64; it += G) {
      {
        const int br = it >> 5, mt = it & 31;
        u16* hid = P_HID + (long)br * 8192 * 256;
        {
          const float* p0 = (const float*)(p.ws + OFF_PART) + ((long)br * 8192 + mt * 256) * 256;
          const float* p1 = p0 + (long)2 * 8192 * 256;
          const float* bias = P_BIAS + br * 256;
          const int tidl = TIDX();
#pragma unroll 4
          for (int e = tidl; e < 256 * 64; e += NTHR) {
            const float4 a = ((const float4*)p0)[e], b = ((const float4*)p1)[e];
            const float4 bs = *(const float4*)(bias + (e & 63) * 4);
            uint2 w;
            w.x = pk2(silu_f(a.x + b.x + bs.x), silu_f(a.y + b.y + bs.y));
            w.y = pk2(silu_f(a.z + b.z + bs.z), silu_f(a.w + b.w + bs.w));
            *(uint2*)(hid + (long)mt * 256 * 256 + (long)e * 4) = w;
          }
          __syncthreads();
        }
        gemm_tile(wid_s, [=](int m, int k) { return hid + (long)m * 256 + k; }, P_W2T + (long)br * 128 * 256, 256, mt * 256, 0,
                  [=](int m, int n, float v0, float v1, float v2, float v3) {
                    if (n >= 128) return;
                    const unsigned a = pk2(v0, v1), b = pk2(v2, v3);
                    if (br == 0) {
                      u16* c = P_KC + (long)m * 128 + n;
                      c[0] = (u16)a; c[128] = (u16)(a >> 16); c[256] = (u16)b; c[384] = (u16)(b >> 16);
                    } else {
                      uint2 w; w.x = a; w.y = b;
                      *(uint2*)(P_VCT + ((long)(m >> 7) * 128 + n) * 128 + (m & 127)) = w;
                    }
                  }, lds);
      }
    }
    for (int rep = 0; rep < PROBE_A; ++rep)
    for (int it = blockIdx.x; it < 1536; it += G) nsa_attn_item<0>(wid_s, it, p, lds);
  }
  grid_barrier(wid_s, (unsigned*)(p.ws + OFF_BAR), 8u * (unsigned)G);

  for (int it = blockIdx.x; it < 512; it += G) cmp_item(wid_s, it, p, lds);
  grid_barrier(wid_s, (unsigned*)(p.ws + OFF_BAR), 9u * (unsigned)G);

  for (int rep = 0; rep < PROBE_A; ++rep)
  for (int it = blockIdx.x; it < 1536; it += G) nsa_attn_item<1>(wid_s, it, p, lds);
  grid_barrier(wid_s, (unsigned*)(p.ws + OFF_BAR), 10u * (unsigned)G);

  for (int it = blockIdx.x; it < 128 * 8; it += G) {
    int mt, nt;
    tile_order(it, 128, 8, mt, nt);
    float* xo = p.out;
    gemm8_tile<true, false>(wid_s, P_Y2, P_WB_OUT, 2048, mt * 256, nt * 256,
              [=](int m, int n, float v0, float v1, float v2, float v3) {
                const long o = (long)m * 2048 + n;
                float4 r = *(const float4*)(xo + o);
                r.x += v0; r.y += v1; r.z += v2; r.w += v3;
                *(float4*)(xo + o) = r;
              }, lds);
  }
}

extern "C" void kernel_launch(void* const* d_in, const int* in_sizes, int n_in,
                              void* d_out, int out_size, void* d_ws, size_t ws_size,
                              hipStream_t stream) {
  static int grid_blocks = 0;
  if (!grid_blocks) {
    int dev = 0, cus = 0, per_cu = 0;
    (void)hipGetDevice(&dev);
    (void)hipDeviceGetAttribute(&cus, hipDeviceAttributeMultiprocessorCount, dev);
    (void)hipFuncSetAttribute((const void*)mega, hipFuncAttributeMaxDynamicSharedMemorySize, LDS_BYTES);
    (void)hipOccupancyMaxActiveBlocksPerMultiprocessor(&per_cu, mega, NTHR, LDS_BYTES);
    if (per_cu > 1) per_cu = 1;
    if (per_cu < 1) per_cu = 1;
    grid_blocks = cus * per_cu;
  }
  Params p{};
  const float** pf = (const float**)&p;
  for (int i = 0; i < 27; ++i) pf[i] = (const float*)d_in[i];
  p.out = (float*)d_out;
  p.ws = (char*)d_ws;
  void* args[] = {&p};
  hipError_t e = hipLaunchCooperativeKernel((void*)mega, dim3(grid_blocks), dim3(NTHR), args, LDS_BYTES, stream);
  if (e != hipSuccess) fprintf(stderr, "cooperative launch failed: %s (grid %d)\n", hipGetErrorString(e), grid_blocks);
}
```
